# Optimizing an MI355X kernel written in HIP

```python
import jax, jax.numpy as jnp
from jax import lax
import numpy as np

D_MODEL = 1024
BATCH = 2
SEQ = 8192
DEPTH = 2

GRID_W = 64
NA_HEADS = 16
NA_HEAD_DIM = D_MODEL // NA_HEADS
WIN_H = 8
WIN_W = 16
GQA_Q_HEADS = 16
GQA_KV_HEADS = 4
GQA_HEAD_DIM = D_MODEL // GQA_Q_HEADS
ROPE_THETA = 10000.0
Q_BLOCK = 128
D_FF = D_MODEL * 7 // 2
N_EXPERTS = 8
TOP_K = 2
EPS = 1e-6
N_EVEN = (DEPTH + 1) // 2
N_ODD = DEPTH // 2

kernel_name = "hybrid_natten_axial_gqa_moe_encoder"


def rmsnorm(x, g):
    xf = x.astype(jnp.float32)
    y = xf * lax.rsqrt(jnp.mean(xf * xf, axis=-1, keepdims=True) + EPS)
    return (y * g.astype(jnp.float32)).astype(x.dtype)


def rope_1d(x, pos):
    half = x.shape[-1] // 2
    freqs = ROPE_THETA ** (-jnp.arange(half, dtype=jnp.float32) / half)
    ang = pos.astype(jnp.float32)[:, None] * freqs[None, :]
    cos = jnp.cos(ang)[:, None, :]
    sin = jnp.sin(ang)[:, None, :]
    xf = x.astype(jnp.float32)
    x1, x2 = xf[..., :half], xf[..., half:]
    out = jnp.concatenate([x1 * cos - x2 * sin, x2 * cos + x1 * sin], axis=-1)
    return out.astype(x.dtype)


def axial_rope(x, row_pos, col_pos):
    half = x.shape[-1] // 2
    return jnp.concatenate([rope_1d(x[..., :half], row_pos),
                            rope_1d(x[..., half:], col_pos)], axis=-1)


def swiglu(h, w_gate, w_up, w_down):
    return (jax.nn.silu(h @ w_gate) * (h @ w_up)) @ w_down


def neighborhood_attention(h, w_qkv, rpb, w_o):
    B, S, D = h.shape
    rows = S // GRID_W
    kh = min(WIN_H, rows)
    qkv = (h @ w_qkv).reshape(B, rows, GRID_W, 3, NA_HEADS, NA_HEAD_DIM)
    q = qkv[..., 0, :, :] * (NA_HEAD_DIM ** -0.5)
    k = qkv[..., 1, :, :]
    v = qkv[..., 2, :, :]
    cols = jnp.arange(GRID_W)
    col_start = jnp.clip(cols - WIN_W // 2, 0, GRID_W - WIN_W)
    col_idx = col_start[:, None] + jnp.arange(WIN_W)[None, :]
    col_off = col_idx - cols[:, None] + (WIN_W - 1)

    def row_step(args):
        q_r, r = args
        rs = jnp.clip(r - kh // 2, 0, rows - kh)
        k_band = lax.dynamic_slice_in_dim(k, rs, kh, axis=1)
        v_band = lax.dynamic_slice_in_dim(v, rs, kh, axis=1)
        k_nb = k_band[:, :, col_idx]
        v_nb = v_band[:, :, col_idx]
        row_off = rs + jnp.arange(kh) - r + (WIN_H - 1)
        bias = rpb[:, row_off[None, :, None], col_off[:, None, :]]
        s = jnp.einsum('bqhd,biqjhd->bhqij', q_r, k_nb).astype(jnp.float32)
        s = s + bias.astype(jnp.float32)[None]
        p = jax.nn.softmax(s.reshape(B, NA_HEADS, GRID_W, kh * WIN_W), axis=-1)
        p = p.reshape(B, NA_HEADS, GRID_W, kh, WIN_W).astype(v.dtype)
        return jnp.einsum('bhqij,biqjhd->bqhd', p, v_nb)

    o = lax.map(row_step, (q.transpose(1, 0, 2, 3, 4), jnp.arange(rows)))
    o = o.transpose(1, 0, 2, 3, 4).reshape(B, S, NA_HEADS * NA_HEAD_DIM)
    return o @ w_o


def axial_gqa(h, w_qkv, q_g, k_g, w_o):
    B, S, D = h.shape
    nq = GQA_Q_HEADS * GQA_HEAD_DIM
    nkv = GQA_KV_HEADS * GQA_HEAD_DIM
    groups = GQA_Q_HEADS // GQA_KV_HEADS
    qkv = h @ w_qkv
    q = qkv[..., :nq].reshape(B, S, GQA_Q_HEADS, GQA_HEAD_DIM)
    k = qkv[..., nq:nq + nkv].reshape(B, S, GQA_KV_HEADS, GQA_HEAD_DIM)
    v = qkv[..., nq + nkv:].reshape(B, S, GQA_KV_HEADS, GQA_HEAD_DIM)
    q = rmsnorm(q, q_g)
    k = rmsnorm(k, k_g)
    t = jnp.arange(S)
    row_pos = t // GRID_W
    col_pos = t % GRID_W
    q = axial_rope(q, row_pos, col_pos) * (GQA_HEAD_DIM ** -0.5)
    k = axial_rope(k, row_pos, col_pos)
    nb = S // Q_BLOCK
    qb = q.reshape(B, nb, Q_BLOCK, GQA_KV_HEADS, groups, GQA_HEAD_DIM).transpose(1, 0, 2, 3, 4, 5)

    def block(q_blk):
        s = jnp.einsum('bqkgd,bskd->bkgqs', q_blk, k).astype(jnp.float32)
        p = jax.nn.softmax(s, axis=-1).astype(v.dtype)
        return jnp.einsum('bkgqs,bskd->bqkgd', p, v)

    o = lax.map(block, qb)
    o = o.transpose(1, 0, 2, 3, 4, 5).reshape(B, S, nq)
    return o @ w_o


def moe_swiglu(h, w_router, w_gate, w_up, w_down):
    B, S, D = h.shape
    ht = h.reshape(B * S, D)
    logits = (ht @ w_router).astype(jnp.float32)
    top_vals, top_idx = lax.top_k(logits, TOP_K)
    gates = jax.nn.softmax(top_vals, axis=-1)
    gate_full = jnp.sum(jax.nn.one_hot(top_idx, N_EXPERTS, dtype=jnp.float32) * gates[..., None], axis=1)
    y = jnp.zeros((B * S, D), jnp.float32)
    for e in range(N_EXPERTS):
        y = y + gate_full[:, e:e + 1] * swiglu(ht, w_gate[e], w_up[e], w_down[e]).astype(jnp.float32)
    return y.astype(h.dtype).reshape(B, S, D)


def setup_inputs(seed: int = 0) -> dict:
    key = jax.random.key(seed)
    ks = jax.random.split(key, 16)
    f32 = jnp.float32
    D = D_MODEL
    nq = GQA_Q_HEADS * GQA_HEAD_DIM
    nkv = GQA_KV_HEADS * GQA_HEAD_DIM
    def w(k, shape, fan_in):
        return jax.random.normal(k, shape, f32) * (fan_in ** -0.5)
    return {
        "x": jax.random.normal(ks[0], (BATCH, SEQ, D), f32),
        "norm_g": 1.0 + 0.05 * jax.random.normal(ks[1], (DEPTH, 4, D), f32),
        "na_w_qkv": w(ks[2], (N_EVEN, D, 3 * NA_HEADS * NA_HEAD_DIM), D),
        "na_rpb": 0.02 * jax.random.normal(ks[3], (N_EVEN, NA_HEADS, 2 * WIN_H - 1, 2 * WIN_W - 1), f32),
        "na_w_o": w(ks[4], (N_EVEN, NA_HEADS * NA_HEAD_DIM, D), NA_HEADS * NA_HEAD_DIM),
        "gqa_w_qkv": w(ks[5], (N_ODD, D, nq + 2 * nkv), D),
        "gqa_q_norm": 1.0 + 0.05 * jax.random.normal(ks[6], (N_ODD, GQA_HEAD_DIM), f32),
        "gqa_k_norm": 1.0 + 0.05 * jax.random.normal(ks[7], (N_ODD, GQA_HEAD_DIM), f32),
        "gqa_w_o": w(ks[8], (N_ODD, nq, D), nq),
        "ffn_w_gate": w(ks[9], (N_EVEN, D, D_FF), D),
        "ffn_w_up": w(ks[10], (N_EVEN, D, D_FF), D),
        "ffn_w_down": w(ks[11], (N_EVEN, D_FF, D), D_FF),
        "moe_w_router": w(ks[12], (N_ODD, D, N_EXPERTS), D),
        "moe_w_gate": w(ks[13], (N_ODD, N_EXPERTS, D, D_FF), D),
        "moe_w_up": w(ks[14], (N_ODD, N_EXPERTS, D, D_FF), D),
        "moe_w_down": w(ks[15], (N_ODD, N_EXPERTS, D_FF, D), D_FF),
    }


def reference(x, norm_g, na_w_qkv, na_rpb, na_w_o, gqa_w_qkv, gqa_q_norm, gqa_k_norm, gqa_w_o,
              ffn_w_gate, ffn_w_up, ffn_w_down, moe_w_router, moe_w_gate, moe_w_up, moe_w_down):
    h = x
    for i in range(DEPTH):
        j = i // 2
        a = rmsnorm(h, norm_g[i, 0])
        if i % 2 == 0:
            a = neighborhood_attention(a, na_w_qkv[j], na_rpb[j], na_w_o[j])
        else:
            a = axial_gqa(a, gqa_w_qkv[j], gqa_q_norm[j], gqa_k_norm[j], gqa_w_o[j])
        h = h + rmsnorm(a, norm_g[i, 1])
        f = rmsnorm(h, norm_g[i, 2])
        if i % 2 == 0:
            f = swiglu(f, ffn_w_gate[j], ffn_w_up[j], ffn_w_down[j])
        else:
            f = moe_swiglu(f, moe_w_router[j], moe_w_gate[j], moe_w_up[j], moe_w_down[j])
        h = h + rmsnorm(f, norm_g[i, 3])
    return h
```

```cpp
#include <hip/hip_runtime.h>
#include <cstdio>
#include <cstdint>
namespace pg8 {
#define PG8_LAS __attribute__((address_space(3)))
typedef unsigned short bf16_t;
typedef short bf16x8 __attribute__((ext_vector_type(8)));
typedef float f32x4 __attribute__((ext_vector_type(4)));
typedef unsigned u32x4 __attribute__((ext_vector_type(4)));
constexpr int BM = 256, BK = 64, HALF = 128, HTB = HALF * BK * 2  , STAGE_BYTES = 8 * HTB, NXCD = 8, WGM = 8;

__host__ __device__ __forceinline__ int lds_byte(int r, int c) { const int st = (r >> 4) * 2 + (c >> 5), rr = r & 15, cc = c & 31, ob = rr * 64 + cc * 2; return st * 1024 + (ob ^ (((ob >> 9) & 1) << 5)); }
__host__ __device__ __forceinline__ void stage_rc(int b, int& R, int& C) { const int st = b / 1024, sb = b % 1024, swz = sb ^ (((sb >> 9) & 1) << 5); R = (st >> 1) * 16 + swz / 64; C = (st & 1) * 32 + (swz % 64) / 2; }
__host__ __device__ __forceinline__ int perm32(int rho) { const int n = rho >> 4, i = rho & 15; return 8 * (i >> 2) + 4 * n + (i & 3); }

struct Unit { int pm, pn, eb; };
struct Gemm { const bf16_t* A; const bf16_t* Bt; int M, N, K; size_t bstride; };

struct StaticOrder {
    int nM, nN, nwg, G, c;
    __host__ __device__ void init(int M, int N, int G_, int c_) { nM = M / BM; nN = N / BM; nwg = nM * nN; G = G_; c = c_; }
    __host__ __device__ bool next(int i, Unit& u) const {
        const long L = (long)i * G + c; if (L >= nwg) return false;
        int wgid = (int)L; { const int q = nwg / NXCD, r = nwg % NXCD, xcd = wgid % NXCD, off = wgid / NXCD; wgid = (xcd < r ? xcd * (q + 1) : r * (q + 1) + (xcd - r) * q) + off; }
        const int nig = WGM * nN, gid = wgid / nig, fm = gid * WGM, gsz = (nM - fm) < WGM ? (nM - fm) : WGM;
        u.pm = fm + ((wgid % nig) % gsz); u.pn = (wgid % nig) / gsz; u.eb = 0; return true;
    }
    __device__ __forceinline__ void a_ready(const Unit&) const {}
    __device__ __forceinline__ void done(const Unit&) const {}
};

__device__ __forceinline__ unsigned cvt_pk_bf16(float lo, float hi) { unsigned r; asm volatile("v_cvt_pk_bf16_f32 %0, %1, %2" : "=v"(r) : "v"(lo), "v"(hi)); return r; }
typedef float f32x2 __attribute__((ext_vector_type(2)));
__device__ __forceinline__ f32x2 gelu_pk(f32x2 v) {
    const f32x2 av = __builtin_elementwise_abs(v), d = av * 0.2316418882f + 1.0f;
    f32x2 t; t.x = __builtin_amdgcn_rcpf(d.x); t.y = __builtin_amdgcn_rcpf(d.y);
    f32x2 q = t * 0.5307027145f + (-0.7265760135f); q = q * t + 0.7107068705f; q = q * t + (-0.142248368f); q = q * t + 0.127414796f; q = q * t;
    const f32x2 s = (v * v) * (-0.72134752044f);
    f32x2 e; e.x = __builtin_amdgcn_exp2f(s.x); e.y = __builtin_amdgcn_exp2f(s.y);
    const f32x2 m = v * (q * e), r = v - m;
    f32x2 o; o.x = v.x < 0.f ? m.x : r.x; o.y = v.y < 0.f ? m.y : r.y; return o;
}

template <int ACT  > struct EpiBf16 {
    static constexpr bool PERM = true, AFTER_DRAIN = false; static_assert(ACT == 0 || ACT == 1, "EpiBf16: ACT is 0 (none) or 1 (gelu_pk)");
    bf16_t* O; int ldc; const float* bias; int split_cols; size_t split_stride; float scale0;
    __device__ __forceinline__ void operator()(const f32x4 (&acc)[2][2][4][2], const Unit& u, int wr, int wc, int fr, int fq) const {
        const int row0 = u.pm * BM + wr * 64 + fr; int colt = u.pn * BM; bf16_t* base = O;
        float sc = 1.f; if (split_cols) { const int t = colt / split_cols; base += (size_t)t * split_stride; colt -= t * split_cols; if (t == 0) sc = scale0; }
        const int col0 = colt + wc * 32 + 8 * fq, bcol0 = u.pn * BM + wc * 32 + 8 * fq;
        f32x4 bv[2][2];
#pragma unroll
        for (int bj = 0; bj < 2; ++bj)
#pragma unroll
            for (int n = 0; n < 2; ++n) bv[bj][n] = bias ? *(const f32x4*)(bias + bcol0 + bj * HALF + 4 * n) : (f32x4){0.f, 0.f, 0.f, 0.f};
#pragma unroll
        for (int ai = 0; ai < 2; ++ai)
#pragma unroll
            for (int m = 0; m < 4; ++m) { bf16_t* rowp = base + (size_t)(row0 + ai * HALF + m * 16) * ldc + col0;
#pragma unroll
                for (int bj = 0; bj < 2; ++bj) { f32x4 v0 = acc[ai][bj][m][0] + bv[bj][0], v1 = acc[ai][bj][m][1] + bv[bj][1];
                    if (ACT == 1) { f32x2 a = gelu_pk((f32x2){v0[0], v0[1]}), b = gelu_pk((f32x2){v0[2], v0[3]}), c = gelu_pk((f32x2){v1[0], v1[1]}), d = gelu_pk((f32x2){v1[2], v1[3]});
                        v0 = (f32x4){a.x, a.y, b.x, b.y}; v1 = (f32x4){c.x, c.y, d.x, d.y}; }
                    v0 = v0 * sc; v1 = v1 * sc; u32x4 w; w.x = cvt_pk_bf16(v0[0], v0[1]); w.y = cvt_pk_bf16(v0[2], v0[3]); w.z = cvt_pk_bf16(v1[0], v1[1]); w.w = cvt_pk_bf16(v1[2], v1[3]);
                    *(u32x4*)(rowp + bj * HALF) = w; } }
    }
};

struct EpiQkvGqa {
    static constexpr bool PERM = true, AFTER_DRAIN = false;
    bf16_t* Q; size_t kv_stride;
    __device__ __forceinline__ void operator()(const f32x4 (&acc)[2][2][4][2], const Unit& u, int wr, int wc, int fr, int fq) const {
        const int row0 = u.pm * BM + wr * 64 + fr;
        const int tsel = u.pn < 4 ? 0 : u.pn - 3;
        bf16_t* base = Q + (size_t)tsel * kv_stride; const int ldc = u.pn < 4 ? 1024 : 256; const int col0 = (u.pn < 4 ? u.pn * BM : 0) + wc * 32 + 8 * fq;
#pragma unroll
        for (int ai = 0; ai < 2; ++ai)
#pragma unroll
            for (int m = 0; m < 4; ++m) { bf16_t* rowp = base + (size_t)(row0 + ai * HALF + m * 16) * ldc + col0;
#pragma unroll
                for (int bj = 0; bj < 2; ++bj) { const f32x4 v0 = acc[ai][bj][m][0], v1 = acc[ai][bj][m][1];
                    u32x4 w; w.x = cvt_pk_bf16(v0[0], v0[1]); w.y = cvt_pk_bf16(v0[2], v0[3]); w.z = cvt_pk_bf16(v1[0], v1[1]); w.w = cvt_pk_bf16(v1[2], v1[3]);
                    *(u32x4*)(rowp + bj * HALF) = w; } }
    }
};
__device__ __forceinline__ float silu_mul(float g, float u) { return g * __builtin_amdgcn_rcpf(1.0f + __builtin_amdgcn_exp2f(g * -1.4426950408889634f)) * u; }
struct EpiSwiglu {
    static constexpr bool PERM = true, AFTER_DRAIN = false;
    bf16_t* O; int ldc;
    __device__ __forceinline__ void operator()(const f32x4 (&acc)[2][2][4][2], const Unit& u, int wr, int wc, int fr, int fq) const {
        const int row0 = u.pm * BM + wr * 64 + fr, col0 = u.pn * HALF + wc * 32 + 8 * fq;
#pragma unroll
        for (int ai = 0; ai < 2; ++ai)
#pragma unroll
            for (int m = 0; m < 4; ++m) { bf16_t* rowp = O + (size_t)(row0 + ai * HALF + m * 16) * ldc + col0;
                const f32x4 g0 = acc[ai][0][m][0], g1 = acc[ai][0][m][1], u0 = acc[ai][1][m][0], u1 = acc[ai][1][m][1];
                u32x4 w; w.x = cvt_pk_bf16(silu_mul(g0[0], u0[0]), silu_mul(g0[1], u0[1])); w.y = cvt_pk_bf16(silu_mul(g0[2], u0[2]), silu_mul(g0[3], u0[3]));
                w.z = cvt_pk_bf16(silu_mul(g1[0], u1[0]), silu_mul(g1[1], u1[1])); w.w = cvt_pk_bf16(silu_mul(g1[2], u1[2]), silu_mul(g1[3], u1[3]));
                *(u32x4*)rowp = w; }
    }
};
struct MoeOrder : StaticOrder {
    const volatile PG8_LAS int* ts;
    __device__ __forceinline__ bool next(int i, Unit& u) const {
        if (!StaticOrder::next(i, u)) return false;
        int e = 0;
#pragma unroll
        for (int j = 1; j < 8; ++j) e += (u.pm >= ts[j]) ? 1 : 0;
        u.eb = __builtin_amdgcn_readfirstlane(e); return true;
    }
};
template <class Epi, class Sched, bool ALIGN_EPI = false, bool SP2 = false>
__device__ __forceinline__ void gemm_phase(PG8_LAS unsigned char* lds, const Gemm g, const Sched& S, const Epi& E) {
    int tid_ = threadIdx.x; asm volatile("" : "+v"(tid_));
    const int tid = tid_, wid = __builtin_amdgcn_readfirstlane(tid >> 6), lane = tid & 63, wr = wid >> 2, wc = wid & 3, fr = lane & 15, fq = lane >> 4;
    const int K = g.K, nt = K / BK;
    unsigned voffA[2], voffB[2];
#pragma unroll
    for (int i = 0; i < 2; ++i) { int R, C; stage_rc(tid * 16 + i * 8192, R, C); const int Rb = Epi::PERM ? ((R & ~31) + perm32(R & 31)) : R;
        voffA[i] = (unsigned)(R * K + C) * 2u; voffB[i] = (unsigned)(Rb * K + C) * 2u; }
    const size_t kstep = (size_t)(BK * 2);
    const size_t hstep = (size_t)HALF * K * 2;
    const size_t tstep = 2 * hstep;
    const unsigned ldsw = (unsigned)wid * 1024u;
    const int aoff = lds_byte(wr * 64 + fr, fq * 8), boff = lds_byte(wc * 32 + fr, fq * 8);
#define PG8_SA(b, h) (((b) * 2 + (h)) * HTB)
#define PG8_SB(b, h) ((4 + (b) * 2 + (h)) * HTB)
#define PG8_STAGE(bufoff, gbase, voff) do { _Pragma("unroll") for (int _i = 0; _i < 2; ++_i) \
        __builtin_amdgcn_global_load_lds((const unsigned*)((const char*)(gbase) + (voff)[_i]), (PG8_LAS unsigned*)(lds + (bufoff) + ldsw + _i * 8192), 16, 0, 0); } while (0)
#define PG8_LDA(dst, b, h) do { _Pragma("unroll") for (int m = 0; m < 4; ++m) _Pragma("unroll") for (int k = 0; k < 2; ++k) dst[m][k] = *(const PG8_LAS bf16x8*)(lds + PG8_SA(b, h) + aoff + m * 2048 + k * 1024); } while (0)
#define PG8_LDB(dst, b, h) do { _Pragma("unroll") for (int n = 0; n < 2; ++n) _Pragma("unroll") for (int k = 0; k < 2; ++k) dst[n][k] = *(const PG8_LAS bf16x8*)(lds + PG8_SB(b, h) + boff + n * 2048 + k * 1024); } while (0)
#define PG8_MMA(ai, bj, At, Bt) do { __builtin_amdgcn_s_setprio(1); _Pragma("unroll") for (int m = 0; m < 4; ++m) _Pragma("unroll") for (int n = 0; n < 2; ++n) _Pragma("unroll") for (int k = 0; k < 2; ++k) \
        acc[ai][bj][m][n] = __builtin_amdgcn_mfma_f32_16x16x32_bf16(Bt[n][k], At[m][k], acc[ai][bj][m][n], 0, 0, 0); __builtin_amdgcn_s_setprio(0); } while (0)
#define PG8_WAIT_V(n) asm volatile("s_waitcnt vmcnt(" #n ")" ::: "memory")
#define PG8_WAIT_L(n) asm volatile("s_waitcnt lgkmcnt(" #n ")" ::: "memory")
#define PG8_BAR __builtin_amdgcn_s_barrier()
#define PG8_SCHED __builtin_amdgcn_sched_barrier(0)
    Unit cur, nxt; int ui = 0;
    if (!S.next(0, cur)) return;
    f32x4 acc[2][2][4][2];
#pragma unroll
    for (int a = 0; a < 2; ++a)
#pragma unroll
        for (int b = 0; b < 2; ++b)
#pragma unroll
            for (int m = 0; m < 4; ++m)
#pragma unroll
                for (int n = 0; n < 2; ++n) acc[a][b][m][n] = (f32x4){0.f, 0.f, 0.f, 0.f};
    bf16x8 At[4][2], B0[2][2], B1[2][2];
    const char* cA = (const char*)g.A + (size_t)cur.pm * tstep; const char* cB = (const char*)g.Bt + (size_t)cur.eb * g.bstride + (size_t)cur.pn * tstep;
    S.a_ready(cur);
    if constexpr (SP2) {
        PG8_STAGE(PG8_SB(0, 0), cB, voffB); PG8_STAGE(PG8_SB(0, 1), cB + hstep, voffB); PG8_STAGE(PG8_SA(0, 0), cA, voffA); PG8_STAGE(PG8_SA(0, 1), cA + hstep, voffA);
        if (wr == 1) PG8_BAR;
        PG8_WAIT_V(2); PG8_BAR;
        PG8_STAGE(PG8_SB(1, 0), cB + kstep, voffB); PG8_STAGE(PG8_SA(1, 0), cA + kstep, voffA); PG8_STAGE(PG8_SB(1, 1), cB + hstep + kstep, voffB);
        PG8_WAIT_V(6); PG8_BAR;
    } else {
        PG8_STAGE(PG8_SB(0, 0), cB, voffB); PG8_STAGE(PG8_SA(0, 0), cA, voffA); PG8_STAGE(PG8_SB(0, 1), cB + hstep, voffB); PG8_STAGE(PG8_SA(0, 1), cA + hstep, voffA);
        if (wr == 1) PG8_BAR;
        PG8_WAIT_V(4); PG8_BAR;
        PG8_STAGE(PG8_SB(1, 0), cB + kstep, voffB); PG8_STAGE(PG8_SA(1, 0), cA + kstep, voffA); PG8_STAGE(PG8_SB(1, 1), cB + hstep + kstep, voffB);
        PG8_WAIT_V(6); PG8_BAR;
    }
    for (;;) {
        const bool has_next = S.next(ui + 1, nxt);
        const char* nA = has_next ? (const char*)g.A + (size_t)nxt.pm * tstep : cA; const char* nB = has_next ? (const char*)g.Bt + (size_t)nxt.eb * g.bstride + (size_t)nxt.pn * tstep : cB;
        for (int t = 0; t < nt; t += 2) {
            const bool last = (t == nt - 2);
            const char* a1 = cA + (size_t)(t + 1) * kstep;
            const char* a2 = last ? nA : cA + (size_t)(t + 2) * kstep; const char* b2 = last ? nB : cB + (size_t)(t + 2) * kstep;
            const char* a3 = a2 + kstep; const char* b3 = b2 + kstep;
            if (last && has_next) S.a_ready(nxt);
            if constexpr (SP2) {
            PG8_LDB(B0, 0, 0); PG8_LDB(B1, 0, 1); PG8_SCHED; PG8_LDA(At, 0, 0); PG8_STAGE(PG8_SA(1, 1), a1 + hstep, voffA);
            PG8_WAIT_V(8); PG8_WAIT_L(0); PG8_BAR; PG8_MMA(0, 0, At, B0); PG8_MMA(0, 1, At, B1); PG8_BAR; PG8_SCHED;
            PG8_LDA(At, 0, 1); PG8_STAGE(PG8_SB(0, 0), b2, voffB); PG8_STAGE(PG8_SB(0, 1), b2 + hstep, voffB); PG8_STAGE(PG8_SA(0, 0), a2, voffA);
            PG8_WAIT_V(8); PG8_WAIT_L(0); PG8_BAR; PG8_MMA(1, 0, At, B0); PG8_MMA(1, 1, At, B1); PG8_BAR; PG8_SCHED;
            PG8_LDB(B0, 1, 0); PG8_LDB(B1, 1, 1); PG8_SCHED; PG8_LDA(At, 1, 0); PG8_STAGE(PG8_SA(0, 1), a2 + hstep, voffA);
            PG8_WAIT_V(8); PG8_WAIT_L(0); PG8_BAR; PG8_MMA(0, 0, At, B0); PG8_MMA(0, 1, At, B1); PG8_BAR; PG8_SCHED;
            PG8_LDA(At, 1, 1); PG8_STAGE(PG8_SB(1, 0), b3, voffB); PG8_STAGE(PG8_SB(1, 1), b3 + hstep, voffB); PG8_STAGE(PG8_SA(1, 0), a3, voffA);
            PG8_WAIT_V(8); PG8_WAIT_L(0); PG8_BAR; PG8_MMA(1, 0, At, B0); PG8_MMA(1, 1, At, B1); PG8_BAR; PG8_SCHED;
            } else {
            PG8_LDB(B0, 0, 0); PG8_SCHED; PG8_LDA(At, 0, 0); PG8_STAGE(PG8_SA(1, 1), a1 + hstep, voffA);
            PG8_WAIT_L(8); PG8_BAR; PG8_WAIT_L(0); PG8_MMA(0, 0, At, B0); PG8_BAR; PG8_SCHED;
            PG8_LDB(B1, 0, 1); PG8_STAGE(PG8_SB(0, 0), b2, voffB);
            PG8_BAR; PG8_WAIT_L(0); PG8_MMA(0, 1, At, B1); PG8_BAR;
            PG8_LDA(At, 0, 1); PG8_STAGE(PG8_SA(0, 0), a2, voffA);
            PG8_BAR; PG8_WAIT_L(0); PG8_MMA(1, 0, At, B0); PG8_BAR; PG8_SCHED;
            PG8_STAGE(PG8_SB(0, 1), b2 + hstep, voffB);
            PG8_WAIT_V(6); PG8_BAR; PG8_MMA(1, 1, At, B1); PG8_BAR;
            PG8_LDB(B0, 1, 0); PG8_SCHED; PG8_LDA(At, 1, 0); PG8_STAGE(PG8_SA(0, 1), a2 + hstep, voffA);
            PG8_WAIT_L(8); PG8_BAR; PG8_WAIT_L(0); PG8_MMA(0, 0, At, B0); PG8_BAR; PG8_SCHED;
            PG8_LDB(B1, 1, 1); PG8_STAGE(PG8_SB(1, 0), b3, voffB);
            PG8_BAR; PG8_WAIT_L(0); PG8_MMA(0, 1, At, B1); PG8_BAR;
            PG8_LDA(At, 1, 1); PG8_STAGE(PG8_SA(1, 0), a3, voffA);
            PG8_BAR; PG8_WAIT_L(0); PG8_MMA(1, 0, At, B0); PG8_BAR; PG8_SCHED;
            PG8_STAGE(PG8_SB(1, 1), b3 + hstep, voffB);
            PG8_WAIT_V(6); PG8_BAR; PG8_MMA(1, 1, At, B1); PG8_BAR;
            }
        }
        if constexpr (ALIGN_EPI) { if (wr == 0) PG8_BAR; }
        if constexpr (!Epi::AFTER_DRAIN) { E(acc, cur, wr, wc, fr, fq); S.done(cur); }
        if (!has_next) break;
#pragma unroll
        for (int a = 0; a < 2; ++a)
#pragma unroll
            for (int b = 0; b < 2; ++b)
#pragma unroll
                for (int m = 0; m < 4; ++m)
#pragma unroll
                    for (int n = 0; n < 2; ++n) acc[a][b][m][n] = (f32x4){0.f, 0.f, 0.f, 0.f};
        cur = nxt; cA = nA; cB = nB; ++ui;
        if constexpr (ALIGN_EPI) { if (wr == 1) PG8_BAR; }
    }
    PG8_WAIT_V(0);
    if constexpr (!ALIGN_EPI) { if (wr == 0) PG8_BAR; }
    PG8_BAR;
    if constexpr (Epi::AFTER_DRAIN) { E.fused(acc, cur, wr, wc, fr, fq, lds, wid, lane); S.done(cur); }
#undef PG8_SA
#undef PG8_SB
#undef PG8_STAGE
#undef PG8_LDA
#undef PG8_LDB
#undef PG8_MMA
#undef PG8_WAIT_V
#undef PG8_WAIT_L
#undef PG8_BAR
#undef PG8_SCHED
}
}

#ifndef PG8_SP2
#define PG8_SP2 true
#endif
#ifndef PG8_ALIGN
#define PG8_ALIGN true
#endif
#include <hip/hip_bf16.h>
#include <cmath>
namespace attn_body {
using bf16=__hip_bfloat16;
using bf16x8=__attribute__((ext_vector_type(8)))short;
using s16x4=__attribute__((ext_vector_type(4)))short;
using f32x16=__attribute__((ext_vector_type(16)))float;
using u32x4=__attribute__((ext_vector_type(4)))unsigned;
constexpr int BATCH=2,NHEAD=16,SEQ=8192,D=64;
constexpr int NW=8,QBLK=32,QB=QBLK*NW,KVBLK=64,NQB=SEQ/QB;
constexpr int ATTN_UNIT_ROWS=QB;
__device__ __forceinline__ int crow(int r,int hi){return (r&3)+8*(r>>2)+4*hi;}
#define SBAR() __builtin_amdgcn_sched_barrier(0)
typedef __attribute__((address_space(3))) const float* lds_fptr;
constexpr float NA_NEG=-1000.f;
__device__ __forceinline__ void namask(f32x16&p0,f32x16&p1,int t,int rowlo,int robase,lds_fptr tr0,int vbase){
  if((unsigned)(t-rowlo)>=8u){
    #pragma unroll
    for(int r=0;r<16;++r){p0[r]=NA_NEG;p1[r]=NA_NEG;}
  }else{
    lds_fptr tr=tr0+(robase+t)*128;
    #pragma unroll
    for(int r=0;r<16;++r){const int k0=(r&3)+8*(r>>2);
      const float b0=tr[k0],b1=tr[k0+32];
      p0[r]=((unsigned)(k0+vbase)<16u)?p0[r]+b0:NA_NEG;
      p1[r]=((unsigned)(k0+32+vbase)<16u)?p1[r]+b1:NA_NEG;}
  }
}
constexpr int NSLOT=3, SLOTB=8192;
constexpr int LDS_K=0, LDS_V=NSLOT*SLOTB, LDS_WS=2*NSLOT*SLOTB, LDS_OST=LDS_WS+NW*64*4, LDS_BYTES=LDS_OST+NW*4096;
constexpr float C2=0.125f*1.4426950408889634f;
__device__ __forceinline__ void glds16(const void*gsrc,unsigned lds_dst){unsigned keep;
  asm volatile("s_mov_b32 %0, m0\n\ts_mov_b32 m0, %2\n\ts_nop 0\n\tglobal_load_lds_dwordx4 %1, off\n\ts_mov_b32 m0, %0":"=&s"(keep):"v"(gsrc),"s"(lds_dst):"memory");}
__device__ __forceinline__ float max3f(float a,float b,float c){float r;asm("v_max3_f32 %0, %1, %2, %3":"=v"(r):"v"(a),"v"(b),"v"(c));return r;}
__device__ __forceinline__ float max2f(float a,float b){float r;asm("v_max_f32_e32 %0, %1, %2":"=v"(r):"v"(a),"v"(b));return r;}
__device__ __forceinline__ float fadd_s(float a,float b){float r;asm("v_add_f32_e32 %0, %1, %2":"=v"(r):"v"(a),"v"(b));return r;}
__device__ __forceinline__ float fsub_s(float a,float b){float r;asm("v_sub_f32_e32 %0, %1, %2":"=v"(r):"v"(a),"v"(b));return r;}
typedef float f32x2_t __attribute__((ext_vector_type(2))); typedef __bf16 bf16x2_t __attribute__((ext_vector_type(2)));
__device__ __forceinline__ unsigned cvtpk_s(float lo,float hi){f32x2_t v={lo,hi};bf16x2_t b=__builtin_convertvector(v,bf16x2_t);return __builtin_bit_cast(unsigned,b);}
#define WAIT_BAR(N) asm volatile("s_waitcnt vmcnt(" #N ") lgkmcnt(0)\n\ts_barrier":::"memory")

__device__ __forceinline__ void qkt(f32x16&p0,f32x16&p1,const char*Kslot,const bf16x8*qr,const f32x16&negm,int r32,int hi){
  const char*kb=Kslot+hi*1024+r32*16;
  #pragma unroll
  for(int d0=0;d0<4;++d0){
    const bf16x8 b0=*reinterpret_cast<const bf16x8*>(kb+d0*2048);
    const bf16x8 b1=*reinterpret_cast<const bf16x8*>(kb+d0*2048+512);
    if(d0==0){p0=__builtin_amdgcn_mfma_f32_32x32x16_bf16(b0,qr[0],negm,0,0,0);p1=__builtin_amdgcn_mfma_f32_32x32x16_bf16(b1,qr[0],negm,0,0,0);}
    else{p0=__builtin_amdgcn_mfma_f32_32x32x16_bf16(b0,qr[d0],p0,0,0,0);p1=__builtin_amdgcn_mfma_f32_32x32x16_bf16(b1,qr[d0],p1,0,0,0);}}
}
typedef __attribute__((address_space(3))) const char* lds_cptr;
typedef short v4i16_t __attribute__((ext_vector_type(4)));
__device__ __forceinline__ void kload8(bf16x8*kf,lds_cptr kp){
  kf[0]=*(const __attribute__((address_space(3))) bf16x8*)(kp);      kf[1]=*(const __attribute__((address_space(3))) bf16x8*)(kp+512);
  kf[2]=*(const __attribute__((address_space(3))) bf16x8*)(kp+2048); kf[3]=*(const __attribute__((address_space(3))) bf16x8*)(kp+2560);
  kf[4]=*(const __attribute__((address_space(3))) bf16x8*)(kp+4096); kf[5]=*(const __attribute__((address_space(3))) bf16x8*)(kp+4608);
  kf[6]=*(const __attribute__((address_space(3))) bf16x8*)(kp+6144); kf[7]=*(const __attribute__((address_space(3))) bf16x8*)(kp+6656);
}
__device__ __forceinline__ void kload2(bf16x8*kf,lds_cptr kp,int j){ kf[2*j]=*(const __attribute__((address_space(3))) bf16x8*)(kp+j*2048); kf[2*j+1]=*(const __attribute__((address_space(3))) bf16x8*)(kp+j*2048+512); }
__device__ __forceinline__ s16x4 vtr(lds_cptr p){ return __builtin_bit_cast(s16x4,__builtin_amdgcn_ds_read_tr16_b64_v4i16((__attribute__((address_space(3))) v4i16_t*)p)); }
__device__ __forceinline__ float rowmax(const f32x16&p0,const f32x16&p1){
  float a=max3f(p0[0],p0[1],p1[0]),b=max3f(p0[2],p0[3],p1[1]);a=max3f(a,p1[2],p1[3]);
  #pragma unroll
  for(int r=4;r<16;r+=4){a=max3f(a,p0[r],p0[r+1]);b=max3f(b,p0[r+2],p0[r+3]);a=max3f(a,p1[r],p1[r+1]);b=max3f(b,p1[r+2],p1[r+3]);}
  const float m=max2f(a,b);
  auto rr=__builtin_amdgcn_permlane32_swap(__float_as_uint(m),__float_as_uint(m),false,false);
  return max2f(__uint_as_float(rr[0]),__uint_as_float(rr[1]));
}
__device__ __forceinline__ void pv(f32x16*o,int vb,bf16x8 pa0,bf16x8 pa1,bf16x8 pa2,bf16x8 pa3){
  #pragma unroll
  for(int d0=0;d0<2;++d0){s16x4 lo[4],hi[4];
    #pragma unroll
    for(int ks=0;ks<4;++ks){
      asm volatile("ds_read_b64_tr_b16 %0,%1 offset:%c2":"=&v"(lo[ks]):"v"(vb),"i"(d0*4096+ks*1024):"memory");
      asm volatile("ds_read_b64_tr_b16 %0,%1 offset:%c2":"=&v"(hi[ks]):"v"(vb),"i"(d0*4096+ks*1024+512):"memory");}
    asm volatile("s_waitcnt lgkmcnt(0)":::"memory");SBAR();
    #define PK(k) (bf16x8){lo[k][0],lo[k][1],lo[k][2],lo[k][3],hi[k][0],hi[k][1],hi[k][2],hi[k][3]}
    o[d0]=__builtin_amdgcn_mfma_f32_32x32x16_bf16(pa0,PK(0),o[d0],0,0,0);
    o[d0]=__builtin_amdgcn_mfma_f32_32x32x16_bf16(pa1,PK(1),o[d0],0,0,0);
    o[d0]=__builtin_amdgcn_mfma_f32_32x32x16_bf16(pa2,PK(2),o[d0],0,0,0);
    o[d0]=__builtin_amdgcn_mfma_f32_32x32x16_bf16(pa3,PK(3),o[d0],0,0,0);
    #undef PK
  }
}

#ifndef ATTN_STORE16
#define ATTN_STORE16(p,v) (*(u32x4*)(p)=(v))
#endif
template<int MODE,int PQ,int PK,int THRL> __device__ __forceinline__ void attn_unit(int b,int hq,int hk,int q0,int k0,int NT,const bf16*Q,const bf16*__restrict__ K,const bf16*__restrict__ V,bf16*O,char*shm,int na_r0,int na_first,lds_fptr na_tab){
  int tid_=threadIdx.x; asm volatile("":"+v"(tid_)); const int tid=tid_,lane=tid&63,r32=lane&31,hi=lane>>5; const int wid=__builtin_amdgcn_readfirstlane(tid>>6);
  const long rowbase=(long)b*SEQ;
  const bf16*Qw=Q+(rowbase+q0+wid*QBLK)*PQ+hq*D;
  const bf16*Kh=K+(rowbase+k0)*PK+hk*D,*Vh=V+(rowbase+k0)*PK+hk*D;
  const unsigned lds0=(unsigned)(uintptr_t)shm;
  float*wsf=(float*)(shm+LDS_WS)+wid*64;
  const bf16*ksrc=Kh+(long)lane*PK+wid*8;
  const bf16*vsrc=Vh+(long)(16*(wid&3)+(lane>>2))*PK+(wid>>2)*32+(lane&3)*8;
  const unsigned kdst=lds0+LDS_K+wid*1024, vdst=lds0+LDS_V+wid*1024;
  #define DMA_K(t,slot) glds16(ksrc+(long)(t)*KVBLK*PK,(unsigned)__builtin_amdgcn_readfirstlane(kdst+(slot)))
  #define DMA_V(t,slot) glds16(vsrc+(long)(t)*KVBLK*PK,(unsigned)__builtin_amdgcn_readfirstlane(vdst+(slot)))
  const int vb0=(int)(lds0+LDS_V)+((lane>>4)&1)*32+(lane&3)*8+(4*hi+((lane&15)>>2))*64;
  const char*Kbase=shm+LDS_K; bf16x8 kf[8];
  const lds_cptr shm3=(lds_cptr)shm; const lds_cptr kp0=shm3+LDS_K+hi*1024+r32*16; const lds_cptr vp0=shm3+LDS_V+((lane>>4)&1)*32+(lane&3)*8+(4*hi+((lane&15)>>2))*64;
  DMA_K(0,0);DMA_V(0,0);DMA_K(1,SLOTB);
  bf16x8 qr[4];
  #pragma unroll
  for(int d0=0;d0<4;++d0)qr[d0]=*reinterpret_cast<const bf16x8*>(&Qw[(long)r32*PQ+d0*16+hi*8]);
  float mhat=0.f,l_reg=0.f;f32x16 o[2];o[0]=f32x16{};o[1]=f32x16{};f32x16 negm=f32x16{};asm volatile("":"+v"(negm));
  int na_rowlo=0,na_robase=0,na_vbase=0; lds_fptr na_tr0=na_tab;
  if constexpr(MODE==1){ const int r_=na_r0+(wid>>1), c_=32*(wid&1)+r32; int rs_=r_-4; rs_=rs_<0?0:(rs_>SEQ/64-8?SEQ/64-8:rs_); int cs_=c_-8; cs_=cs_<0?0:(cs_>48?48:cs_);
    na_rowlo=__builtin_amdgcn_readfirstlane(rs_-na_first); na_robase=__builtin_amdgcn_readfirstlane(na_first-r_+7); na_vbase=4*hi-cs_; na_tr0=na_tab+(64-c_+4*hi); }
  #define CMASK(P0,P1,t) do{ if constexpr(MODE==1) namask(P0,P1,(t),na_rowlo,na_robase,na_tr0,na_vbase); }while(0)
  bool resc=false;
  #define START(P0,P1) do{ const float rm=rowmax(P0,P1); resc=false; \
    { const float dl=rm; mhat=fadd_s(mhat,dl); \
      _Pragma("unroll") for(int r=0;r<16;++r){P0[r]=fsub_s(P0[r],dl);P1[r]=fsub_s(P1[r],dl);} \
      _Pragma("unroll") for(int r=0;r<16;++r)negm[r]=-mhat; asm volatile("":"+v"(negm)); } \
    _Pragma("unroll") for(int r=0;r<16;++r)P0[r]=__builtin_amdgcn_exp2f(P0[r]); }while(0)
  #define RESC() do{ if(resc){ asm volatile("s_waitcnt lgkmcnt(0)":::"memory"); \
      _Pragma("unroll") for(int d_=0;d_<2;++d_) _Pragma("unroll") for(int r=0;r<16;++r)o[d_][r]*=wsf[crow(r,hi)]; } }while(0)
  f32x16 pA0,pA1,pB0,pB1;
  int sl_prev=0,sl_cur=0,sl_next=SLOTB;
  #define ROT() do{sl_prev=sl_cur;sl_cur=sl_next;sl_next=(sl_next==(NSLOT-1)*SLOTB)?0:sl_next+SLOTB;}while(0)
  DMA_K(2,2*SLOTB);
  WAIT_BAR(3);
  qkt(pA0,pA1,Kbase,qr,negm,r32,hi);asm volatile("s_nop 15\n\ts_nop 7":"+v"(pA0),"+v"(pA1));CMASK(pA0,pA1,0);
  START(pA0,pA1);
  _Pragma("unroll") for(int r=0;r<16;++r)pA1[r]=__builtin_amdgcn_exp2f(pA1[r]);
  WAIT_BAR(0);
  DMA_K(3,0);DMA_V(1,SLOTB);
  ROT();
  kload8(kf,kp0+sl_cur);
  WAIT_BAR(2);
  s16x4 vlo[8],vhi[8]; u32x4 pw0,pw1,pw2,pw3;
  #define PKW(P,B) cvtpk_s(P[B],P[B+1])
  #define PAF(k) __builtin_bit_cast(bf16x8,pw##k)
  #define VFR(i) (bf16x8){vlo[i][0],vlo[i][1],vlo[i][2],vlo[i][3],vhi[i][0],vhi[i][1],vhi[i][2],vhi[i][3]}
  #define PIN(x) asm volatile("":"+v"(x))
  #define MX3(a,b,c) __builtin_fmaxf(__builtin_fmaxf((a),(b)),(c))
  #define GAPA(MF,A0,A1,A2,A3,W0,W1,PW) do{ MF; sacc+=A0; sacc+=A1; sacc+=A2; sacc+=A3; PIN(sacc); W0; W1; PIN(PW); SBAR(); }while(0)
  #define EX(v) __builtin_amdgcn_exp2f(v)
  #define GAPB(MF,X,B) do{ MF; X[B]=EX(X[B]); X[B+1]=EX(X[B+1]); X[B+2]=EX(X[B+2]); X[B+3]=EX(X[B+3]); PIN(X); SBAR(); }while(0)
  #define VRD(i) do{ vlo[i]=vtr(vp_+(((i)>>2)*4096+((i)&3)*1024)); vhi[i]=vtr(vp_+(((i)>>2)*4096+((i)&3)*1024+512)); }while(0)
  #define KRD(G,j) do{ if(G){ kload2(kf,kp0+sl_next,j); SBAR(); } }while(0)
  #define STEP(C0,C1,P0,P1,t,GK,GV,GL) do{ SBAR(); \
    const lds_cptr vp_=vp0+sl_prev; \
    VRD(0); SBAR(); float sacc=(P0[0]+P0[1]); \
    GAPA(C0=__builtin_amdgcn_mfma_f32_32x32x16_bf16(kf[0],qr[0],negm,0,0,0), P0[2],P0[3],P0[4],P0[5],     pw0[0]=PKW(P0,0), pw0[1]=PKW(P0,2), pw0); \
    VRD(4); SBAR(); GAPA(C1=__builtin_amdgcn_mfma_f32_32x32x16_bf16(kf[1],qr[0],negm,0,0,0), P0[6],P0[7],P0[8],P0[9],     pw0[2]=PKW(P0,4), pw0[3]=PKW(P0,6), pw0); \
    VRD(1); SBAR(); GAPA(C0=__builtin_amdgcn_mfma_f32_32x32x16_bf16(kf[2],qr[1],C0,0,0,0),   P0[10],P0[11],P0[12],P0[13], pw1[0]=PKW(P0,8), pw1[1]=PKW(P0,10), pw1); \
    VRD(5); SBAR(); GAPA(C1=__builtin_amdgcn_mfma_f32_32x32x16_bf16(kf[3],qr[1],C1,0,0,0),   P0[14],P0[15],P1[0],P1[1],   pw1[2]=PKW(P0,12),pw1[3]=PKW(P0,14), pw1); \
    VRD(2); SBAR(); GAPA(C0=__builtin_amdgcn_mfma_f32_32x32x16_bf16(kf[4],qr[2],C0,0,0,0),   P1[2],P1[3],P1[4],P1[5],     pw2[0]=PKW(P1,0), pw2[1]=PKW(P1,2), pw2); \
    VRD(6); SBAR(); GAPA(C1=__builtin_amdgcn_mfma_f32_32x32x16_bf16(kf[5],qr[2],C1,0,0,0),   P1[6],P1[7],P1[8],P1[9],     pw2[2]=PKW(P1,4), pw2[3]=PKW(P1,6), pw2); \
    VRD(3); SBAR(); GAPA(C0=__builtin_amdgcn_mfma_f32_32x32x16_bf16(kf[6],qr[3],C0,0,0,0),   P1[10],P1[11],P1[12],P1[13], pw3[0]=PKW(P1,8), pw3[1]=PKW(P1,10), pw3); \
    VRD(7); SBAR(); GAPA(C1=__builtin_amdgcn_mfma_f32_32x32x16_bf16(kf[7],qr[3],C1,0,0,0),   P1[14],P1[15],0.f,0.f,       pw3[2]=PKW(P1,12),pw3[3]=PKW(P1,14), pw3); \
    l_reg+=sacc; \
    if(GK){DMA_K((t)+3,sl_cur);} if(GV){DMA_V((t)+1,sl_next);} \
    CMASK(C0,C1,t); \
    { float a=MX3(C0[0],C0[1],C1[0]),b=MX3(C0[2],C0[3],C1[1]); a=MX3(a,C1[2],C1[3]); \
      _Pragma("unroll") for(int r=4;r<16;r+=4){a=MX3(a,C0[r],C0[r+1]);b=MX3(b,C0[r+2],C0[r+3]);a=MX3(a,C1[r],C1[r+1]);b=MX3(b,C1[r+2],C1[r+3]);} \
      float rm=__builtin_fmaxf(a,b); { auto rr=__builtin_amdgcn_permlane32_swap(__float_as_uint(rm),__float_as_uint(rm),false,false); rm=__builtin_fmaxf(__uint_as_float(rr[0]),__uint_as_float(rr[1])); } \
      resc=false; \
      if(__builtin_expect(__any(rm>(float)THRL),0)){ const float dl=__builtin_fmaxf(rm,0.f); mhat+=dl; \
        _Pragma("unroll") for(int r=0;r<16;++r){C0[r]-=dl;C1[r]-=dl;} \
        _Pragma("unroll") for(int r=0;r<16;++r)negm[r]=-mhat; asm volatile("":"+v"(negm)); \
        const float f=__builtin_amdgcn_exp2f(-dl); l_reg*=f; if(hi==0)wsf[r32]=f; resc=true; } } \
    SBAR(); \
    GAPB(o[0]=__builtin_amdgcn_mfma_f32_32x32x16_bf16(PAF(0),VFR(0),o[0],0,0,0), C0,0); \
    GAPB(o[1]=__builtin_amdgcn_mfma_f32_32x32x16_bf16(PAF(0),VFR(4),o[1],0,0,0), C0,4); \
    KRD(GL,0); GAPB(o[0]=__builtin_amdgcn_mfma_f32_32x32x16_bf16(PAF(1),VFR(1),o[0],0,0,0), C0,8); \
    KRD(GL,1); GAPB(o[1]=__builtin_amdgcn_mfma_f32_32x32x16_bf16(PAF(1),VFR(5),o[1],0,0,0), C0,12); \
    KRD(GL,2); GAPB(o[0]=__builtin_amdgcn_mfma_f32_32x32x16_bf16(PAF(2),VFR(2),o[0],0,0,0), C1,0); \
    KRD(GL,3); GAPB(o[1]=__builtin_amdgcn_mfma_f32_32x32x16_bf16(PAF(2),VFR(6),o[1],0,0,0), C1,4); \
    GAPB(o[0]=__builtin_amdgcn_mfma_f32_32x32x16_bf16(PAF(3),VFR(3),o[0],0,0,0), C1,8); \
    GAPB(o[1]=__builtin_amdgcn_mfma_f32_32x32x16_bf16(PAF(3),VFR(7),o[1],0,0,0), C1,12); \
    }while(0)
  int t=1;
  for(;t+5<NT;t+=2){
    STEP(pB0,pB1,pA0,pA1,t,true,true,true);     WAIT_BAR(2); RESC(); ROT();
    STEP(pA0,pA1,pB0,pB1,t+1,true,true,true);   WAIT_BAR(2); RESC(); ROT();
  }
  #define ENDW(tt) do{ if((tt)+3<NT){WAIT_BAR(2);} else if((tt)+2<NT){WAIT_BAR(1);} else {WAIT_BAR(0);} }while(0)
  for(;t+1<NT;t+=2){
    STEP(pB0,pB1,pA0,pA1,t,(t+3<NT),(t+1<NT),(t+1<NT));       ENDW(t);   RESC(); ROT();
    STEP(pA0,pA1,pB0,pB1,t+1,(t+4<NT),(t+2<NT),(t+2<NT));     ENDW(t+1); RESC(); ROT();
  }
  STEP(pB0,pB1,pA0,pA1,NT-1,false,false,false); RESC();
  { float sacc=pB0[0]+pB0[1]; _Pragma("unroll") for(int r=2;r<16;++r)sacc+=pB0[r]; _Pragma("unroll") for(int r=0;r<16;++r)sacc+=pB1[r]; l_reg+=sacc;
    pw0=(u32x4){PKW(pB0,0),PKW(pB0,2),PKW(pB0,4),PKW(pB0,6)};pw1=(u32x4){PKW(pB0,8),PKW(pB0,10),PKW(pB0,12),PKW(pB0,14)};pw2=(u32x4){PKW(pB1,0),PKW(pB1,2),PKW(pB1,4),PKW(pB1,6)};pw3=(u32x4){PKW(pB1,8),PKW(pB1,10),PKW(pB1,12),PKW(pB1,14)};
    SBAR(); pv(o,vb0+sl_cur,PAF(0),PAF(1),PAF(2),PAF(3)); }
  #undef PKW
  #undef PAF
  #undef VFR
  #undef PIN
  #undef MX3
  #undef GAPA
  #undef GAPB
  #undef EX
  #undef VRD
  #undef KRD
  #undef STEP
  #undef ENDW
  {auto rr=__builtin_amdgcn_permlane32_swap(__float_as_uint(l_reg),__float_as_uint(l_reg),false,false);l_reg=__uint_as_float(rr[0])+__uint_as_float(rr[1]);}
  if(hi==0)wsf[32+r32]=l_reg;asm volatile("s_waitcnt lgkmcnt(0)":::"memory");
  float rli[16];
  #pragma unroll
  for(int r=0;r<16;++r)rli[r]=__builtin_amdgcn_rcpf(wsf[32+crow(r,hi)]);
  bf16*Ow=O+(rowbase+q0+wid*QBLK)*PQ+hq*D;
  { bf16*stg=(bf16*)(shm+LDS_OST)+wid*2048;
    #pragma unroll
    for(int r=0;r<16;++r){const int orow=crow(r,hi);
      #pragma unroll
      for(int d0=0;d0<2;++d0)stg[orow*64+d0*32+r32]=__float2bfloat16(o[d0][r]*rli[r]);}
    asm volatile("s_waitcnt lgkmcnt(0)":::"memory");
    #pragma unroll
    for(int i=0;i<4;++i){const int row=i*8+(lane>>3),ch=lane&7; const u32x4 v=*(const u32x4*)(stg+row*64+ch*8); ATTN_STORE16(Ow+(long)row*PQ+ch*8,v);} }
  asm volatile("s_waitcnt lgkmcnt(0)\n\ts_barrier":::"memory");
  #undef DMA_K
  #undef DMA_V
  #undef CMASK
  #undef START
  #undef RESC
  #undef ROT
}
constexpr int ATTN_LDS_BYTES=LDS_BYTES;
#undef SBAR
#undef WAIT_BAR
}

constexpr int NWAVES = 8;
constexpr int BATCH = 2, SEQ = 8192, D = 1024, M = BATCH * SEQ, FF = 3584, NE = 8;
constexpr int NQKV0 = 3 * D, NQKV1 = D + 2 * 256, NKV = 256, HD = 64;
constexpr float EPS = 1e-6f;
constexpr float LOG2E = 1.4426950408889634f;
constexpr int NCHUNK = M / 64;
constexpr int MOE_MAXT = (M * 2) / 256 + NE;

constexpr size_t MiB = 1u << 20;
constexpr size_t WS_CTL = 0, CTL_ZERO_BYTES = 64 * 1024;
constexpr size_t WS_ROPE = 1 * MiB;
constexpr size_t WS_TOKE = 1 * MiB + 256 * 1024;
constexpr size_t WS_TOKG = 1 * MiB + 512 * 1024;
constexpr size_t WS_SLOT = 1 * MiB + 768 * 1024;
constexpr size_t WS_CCNT = 2 * MiB;
constexpr size_t WS_WGUM = 4 * MiB;
constexpr size_t WS_Y = WS_WGUM;
constexpr size_t WS_R3 = 116 * MiB;
constexpr size_t WS_WQKV0 = WS_R3, WS_WO0 = WS_R3 + 6 * MiB, WS_WQKV1 = WS_R3 + 8 * MiB, WS_WO1 = WS_R3 + 11 * MiB, WS_WGU0 = WS_R3 + 13 * MiB, WS_WD0 = WS_R3 + 27 * MiB;
constexpr size_t WS_APERM = WS_R3, WS_WDM = WS_R3;
constexpr size_t WS_R4 = 184 * MiB;
constexpr size_t WS_XN = WS_R4, WS_Q = WS_R4 + 32 * MiB, WS_K = WS_R4 + 64 * MiB, WS_V = WS_R4 + 96 * MiB, WS_PO = WS_R4 + 128 * MiB, WS_ACT = WS_R4 + 160 * MiB;
constexpr size_t WS_MACT = WS_R4;
constexpr size_t WS_END = 456 * MiB;
static_assert(WS_WD0 + (size_t)D * FF * 2 <= WS_R3 + 68 * MiB && WS_APERM + (size_t)MOE_MAXT * 256 * D * 2 <= WS_R4 && WS_WDM + (size_t)NE * D * FF * 2 <= WS_R4, "R3 map");
static_assert(WS_ACT + (size_t)M * FF * 2 <= WS_END && WS_MACT + (size_t)MOE_MAXT * 256 * FF * 2 <= WS_END && WS_Y + (size_t)MOE_MAXT * 256 * D * 2 <= WS_R3 && WS_WGUM + (size_t)NE * 2 * FF * D * 2 <= WS_R3, "R4 map");
constexpr int CW_TMO = 0;
constexpr int CW_BAR = 1024;

constexpr int RING_OFF = 0, RING_BYTES = 131072;
constexpr int SCR_WAVE = 64 * 65 * 4;
constexpr int NA_TAB_OFF = 90112;
constexpr int LDSCTL_OFF = 135168, MISC_WORDS = 256;
constexpr int LDS_BYTES = 147456;
static_assert(8 * SCR_WAVE <= LDSCTL_OFF && LDSCTL_OFF + MISC_WORDS * 4 <= LDS_BYTES && NA_TAB_OFF + 15 * 128 * 4 <= RING_BYTES, "LDS map");
constexpr int MW_BAR = 8;
constexpr int MW_TS = 16;
constexpr int MW_CNT = 32;
#define GAS __attribute__((address_space(1)))
#define LAS __attribute__((address_space(3)))
typedef unsigned short bf16;
typedef unsigned v4u __attribute__((ext_vector_type(4)));
typedef float f32x4 __attribute__((ext_vector_type(4)));
typedef short bf16x8 __attribute__((ext_vector_type(8)));
typedef GAS unsigned gu32;
typedef GAS unsigned long long gu64;
#define RLX_AGENT __ATOMIC_RELAXED, __HIP_MEMORY_SCOPE_AGENT
#define LDS_WAIT() asm volatile("s_waitcnt lgkmcnt(0)" ::: "memory")
#define VM_WAIT() asm volatile("s_waitcnt vmcnt(0)" ::: "memory")
__device__ __forceinline__ unsigned long long rt() { return __builtin_amdgcn_s_memrealtime(); }
__device__ __forceinline__ unsigned f2bf(float f) { unsigned u = __builtin_bit_cast(unsigned, f); return (u + 0x7fffu + ((u >> 16) & 1u)) >> 16; }
__device__ __forceinline__ unsigned pk2(float lo, float hi) { return f2bf(lo) | (f2bf(hi) << 16); }

#define XB_TMO      128
#define XB_XCNT(j)  (256  + 64 * (j))
#define XB_XSUB(j)  (1280 + 64 * (j))
#define XB_XGEN(j)  (2304 + 64 * (j))
#define XB_TOP      3328
#define XB_TOPGEN   3392
#define XCD_BAR_WORDS 3456
#define XB_SPIN_CAP (1u << 18)

__device__ __forceinline__ unsigned xb_ld(unsigned* p)              { return __hip_atomic_load(p, __ATOMIC_RELAXED, __HIP_MEMORY_SCOPE_AGENT); }
__device__ __forceinline__ unsigned xb_add(unsigned* p, unsigned v) { return __hip_atomic_fetch_add(p, v, __ATOMIC_RELAXED, __HIP_MEMORY_SCOPE_AGENT); }
__device__ __forceinline__ unsigned xb_xcc_id() { return (unsigned)__builtin_amdgcn_s_getreg((3 << 11) | 20) & 0xFu; }
#define XB_SPIN(cond, bar) do { unsigned _sp = 0; while (cond) { __builtin_amdgcn_s_sleep(1); \
    if ((++_sp & 255u) == 0u) { if (xb_ld(&(bar)[XB_TMO])) break; if (_sp > XB_SPIN_CAP) { atomicAdd(&(bar)[XB_TMO], 1u); break; } } } } while (0)

struct XcdBarrier {
    unsigned* bar; unsigned x;
    volatile LAS unsigned* st;
};

__device__ __forceinline__ XcdBarrier xcd_barrier_post(unsigned* bar, volatile LAS unsigned* st) {
    XcdBarrier b; b.bar = bar; b.x = xb_xcc_id(); b.st = st;
    if (threadIdx.x == 0) (void)xb_add(&bar[XB_XCNT(b.x)], 1u);
    return b;
}
__device__ __forceinline__ void xcd_barrier_complete(unsigned* bar, unsigned x, unsigned& nloc, unsigned& nx) {
    const unsigned G = gridDim.x * gridDim.y * gridDim.z;
    unsigned sum, cnt, mine, sp = 0u;
    for (;;) {
        sum = 0u; cnt = 0u; mine = 0u;
#pragma unroll
        for (unsigned j = 0; j < 16; ++j) { const unsigned c = xb_ld(&bar[XB_XCNT(j)]); sum += c; cnt += (c > 0u) ? 1u : 0u; mine = (j == x) ? c : mine; }
        if (sum == G) break;
        __builtin_amdgcn_s_sleep(1);
        if ((++sp & 255u) == 0u) { if (xb_ld(&bar[XB_TMO])) break; if (sp > XB_SPIN_CAP) { atomicAdd(&bar[XB_TMO], 1u); break; } }
    }
    nloc = mine > 0u ? mine : 1u; nx = cnt > 0u ? cnt : 1u;
}

__device__ __forceinline__ void xcd_barrier(const XcdBarrier& b) {
    asm volatile("s_waitcnt vmcnt(0)" ::: "memory");
    __syncthreads();
    if (threadIdx.x == 0) {
        unsigned* bar = b.bar;
        __builtin_amdgcn_s_waitcnt(0);
        unsigned nloc = b.st[0], nx = b.st[1];
        if (nloc == 0u) { xcd_barrier_complete(bar, b.x, nloc, nx); b.st[0] = nloc; b.st[1] = nx; }
        const unsigned old = xb_add(&bar[XB_XSUB(b.x)], 1u);
        const unsigned gen = old / nloc;
        if (old + 1u == (gen + 1u) * nloc) {
            __builtin_amdgcn_fence(__ATOMIC_RELEASE, "agent");
            asm volatile("s_waitcnt vmcnt(0)" ::: "memory");
            const unsigned og = xb_add(&bar[XB_TOP], 1u);
            const unsigned tg = og / nx;
            if (og + 1u == (tg + 1u) * nx) xb_add(&bar[XB_TOPGEN], 1u);
            else XB_SPIN(xb_ld(&bar[XB_TOPGEN]) == tg, bar);
            __builtin_amdgcn_fence(__ATOMIC_ACQUIRE, "agent");
            xb_add(&bar[XB_XGEN(b.x)], 1u);
            asm volatile("s_waitcnt vmcnt(0)" ::: "memory");
        } else {
            XB_SPIN(xb_ld(&bar[XB_XGEN(b.x)]) == gen, bar);
            __builtin_amdgcn_fence(__ATOMIC_ACQUIRE, "agent");
            asm volatile("s_waitcnt vmcnt(0)" ::: "memory");
        }
    }
    __syncthreads();
}

typedef unsigned u32x2 __attribute__((ext_vector_type(2)));
struct Frame {
    LAS unsigned char* lds;
    volatile LAS unsigned* MISC;
    gu32* ctl;
    int tid, lane, wave;
    int vcu, G;
    unsigned char* ws;
};
__device__ __forceinline__ float wave_sum(float v) {
#pragma unroll
    for (int o = 1; o < 64; o <<= 1) v += __shfl_xor(v, o);
    return v;
}
__device__ __forceinline__ f32x4 ld_bf16x4(const bf16* p) { const u32x2 w = *(const GAS u32x2*)p;
    return (f32x4){__uint_as_float(w.x << 16), __uint_as_float(w.x & 0xffff0000u), __uint_as_float(w.y << 16), __uint_as_float(w.y & 0xffff0000u)}; }
__device__ __forceinline__ void st_bf16x4(bf16* p, f32x4 v) { u32x2 w; w.x = pg8::cvt_pk_bf16(v.x, v.y); w.y = pg8::cvt_pk_bf16(v.z, v.w); *(GAS u32x2*)p = w; }
__device__ __forceinline__ float ssq4(const f32x4 (&v)[4]) { float s = 0.f;
#pragma unroll
    for (int j = 0; j < 4; ++j) s += (v[j].x * v[j].x + v[j].y * v[j].y) + (v[j].z * v[j].z + v[j].w * v[j].w);
    return wave_sum(s); }
__device__ __forceinline__ float rms_scale(float ss, int n) { return 1.0f / sqrtf(ss * (1.0f / (float)n) + EPS); }

__device__ __forceinline__ void tr_item(const float* W, int K, int N, bf16* WT, int drow0, int k0, int n0, LAS float* scr, int lane) {
    const int lr = lane >> 4, lc = (lane & 15) * 4;
    f32x4 v[16];
#pragma unroll
    for (int i = 0; i < 16; ++i) v[i] = *(const GAS f32x4*)(W + (size_t)(k0 + 4 * i + lr) * N + n0 + lc);
#pragma unroll
    for (int i = 0; i < 16; ++i) { LAS float* s = scr + (4 * i + lr) * 65 + lc; s[0] = v[i].x; s[1] = v[i].y; s[2] = v[i].z; s[3] = v[i].w; }
    LDS_WAIT(); asm volatile("" ::: "memory");
    const int c = lane & 7, nn = lane >> 3;
#pragma unroll
    for (int j = 0; j < 8; ++j) { const int n = nn + 8 * j; const LAS float* s = scr + (8 * c) * 65 + n;
        v4u o; o.x = pg8::cvt_pk_bf16(s[0 * 65], s[1 * 65]); o.y = pg8::cvt_pk_bf16(s[2 * 65], s[3 * 65]); o.z = pg8::cvt_pk_bf16(s[4 * 65], s[5 * 65]); o.w = pg8::cvt_pk_bf16(s[6 * 65], s[7 * 65]);
        *(GAS v4u*)(WT + (size_t)(drow0 + n) * K + k0 + 8 * c) = o; }
    LDS_WAIT(); asm volatile("" ::: "memory");
}
__device__ __forceinline__ void tr_matrix_item(const float* W, int K, int N, bf16* WT, int mode, int item, LAS float* scr, int lane) {
    const int nblk = N / 64, kb = item / nblk, nb = item % nblk, n0 = 64 * nb;
    const int drow0 = mode == 0 ? n0 : ((n0 >> 7) << 8) + (n0 & 127) + (mode == 2 ? 128 : 0);
    tr_item(W, K, N, WT, drow0, 64 * kb, n0, scr, lane);
}

struct Args { const float* in[16]; float* out; unsigned char* ws; };
enum { I_X = 0, I_NG, I_NAQKV, I_RPB, I_NAO, I_GQKV, I_QN, I_KN, I_GO, I_FG, I_FU, I_FD, I_RT, I_MG, I_MU, I_MD };

__global__ void __launch_bounds__(NWAVES * 64, 2) fwd_kernel(Args args) {
    extern __shared__ __attribute__((aligned(16))) unsigned char lds[];
    Frame F;
    F.lds = (LAS unsigned char*)lds;
    F.MISC = (volatile LAS unsigned*)(F.lds + LDSCTL_OFF);
    F.tid = threadIdx.x; F.lane = F.tid & 63; F.wave = __builtin_amdgcn_readfirstlane(F.tid >> 6);
    F.G = gridDim.x; { const int bx = blockIdx.x; F.vcu = (F.G % 8 == 0) ? (bx % 8) * (F.G / 8) + bx / 8 : bx; }
    F.ws = args.ws; F.ctl = (gu32*)(args.ws + WS_CTL);
    unsigned char* const ws = args.ws;
    for (int u = F.tid; u < MISC_WORDS; u += NWAVES * 64) F.MISC[u] = 0u;
    __syncthreads();
    XcdBarrier bar = xcd_barrier_post((unsigned*)(F.ctl + CW_BAR), F.MISC + MW_BAR);
#define GRID_BAR() xcd_barrier(bar)

    const float* x = args.in[I_X]; const float* norm_g = args.in[I_NG]; float* out = args.out;
    bf16* XN = (bf16*)(ws + WS_XN); bf16* QB = (bf16*)(ws + WS_Q); bf16* KB = (bf16*)(ws + WS_K); bf16* VB = (bf16*)(ws + WS_V); bf16* PO = (bf16*)(ws + WS_PO);
    bf16* ACT = (bf16*)(ws + WS_ACT); bf16* APERM = (bf16*)(ws + WS_APERM); bf16* MACT = (bf16*)(ws + WS_MACT); bf16* YB = (bf16*)(ws + WS_Y);
    int* tok_e = (int*)(ws + WS_TOKE); float* tok_g = (float*)(ws + WS_TOKG); int* slot_of = (int*)(ws + WS_SLOT); int* ccnt = (int*)(ws + WS_CCNT);
    float* rope_tab = (float*)(ws + WS_ROPE);
    const int NGW = F.G * NWAVES;
#define PHASE_IDS() int lane = F.tid & 63; asm volatile("" : "+v"(lane)); const int wave = F.wave; const int colb = 4 * lane; const int gw = F.vcu * NWAVES + wave

    {
        PHASE_IDS();
        LAS float* scr = (LAS float*)(F.lds + RING_OFF + wave * SCR_WAVE);
        constexpr int I_A = 16 * 48, I_B = 16 * 16, I_C = 16 * 24, I_D = 16 * 16, I_E = 16 * 56, I_F = 56 * 16;
        constexpr int NDENSE = I_A + I_B + I_C + I_D + 2 * I_E + I_F, NITEMS = NDENSE + NE * 2 * I_E;
        for (int it = gw; it < NITEMS; it += NGW) {
            int r = it;
            if (r < I_A) { tr_matrix_item(args.in[I_NAQKV], D, NQKV0, (bf16*)(ws + WS_WQKV0), 0, r, scr, lane); continue; } r -= I_A;
            if (r < I_B) { tr_matrix_item(args.in[I_NAO], D, D, (bf16*)(ws + WS_WO0), 0, r, scr, lane); continue; } r -= I_B;
            if (r < I_C) { tr_matrix_item(args.in[I_GQKV], D, NQKV1, (bf16*)(ws + WS_WQKV1), 0, r, scr, lane); continue; } r -= I_C;
            if (r < I_D) { tr_matrix_item(args.in[I_GO], D, D, (bf16*)(ws + WS_WO1), 0, r, scr, lane); continue; } r -= I_D;
            if (r < I_E) { tr_matrix_item(args.in[I_FG], D, FF, (bf16*)(ws + WS_WGU0), 1, r, scr, lane); continue; } r -= I_E;
            if (r < I_E) { tr_matrix_item(args.in[I_FU], D, FF, (bf16*)(ws + WS_WGU0), 2, r, scr, lane); continue; } r -= I_E;
            if (r < I_F) { tr_matrix_item(args.in[I_FD], FF, D, (bf16*)(ws + WS_WD0), 0, r, scr, lane); continue; } r -= I_F;
            const int e = r / (2 * I_E), q = r % (2 * I_E), up = q >= I_E ? 1 : 0;
            tr_matrix_item((up ? args.in[I_MU] : args.in[I_MG]) + (size_t)e * D * FF, D, FF, (bf16*)(ws + WS_WGUM) + (size_t)e * 2 * FF * D, 1 + up, q - up * I_E, scr, lane);
        }
        for (int id = (int)blockIdx.x * (NWAVES * 64) + F.tid; id < 128 * 16; id += F.G * NWAVES * 64) {
            const int pos = id >> 4, i = id & 15; const float fr = exp2f(-(float)i * (13.287712379549449f / 16.0f)); const float ang = (float)pos * fr;
            rope_tab[2 * id] = cosf(ang); rope_tab[2 * id + 1] = sinf(ang);
        }
        f32x4 g0[4];
#pragma unroll
        for (int j = 0; j < 4; ++j) g0[j] = *(const GAS f32x4*)(norm_g + 0 * D + colb + 256 * j);
        for (int m = gw; m < M; m += NGW) {
            f32x4 v[4];
#pragma unroll
            for (int j = 0; j < 4; ++j) v[j] = *(const GAS f32x4*)(x + (size_t)m * D + colb + 256 * j);
            const float r = rms_scale(ssq4(v), D);
#pragma unroll
            for (int j = 0; j < 4; ++j) st_bf16x4(XN + (size_t)m * D + colb + 256 * j, v[j] * r * g0[j]);
        }
    }
    GRID_BAR();

    {
        pg8::Gemm g{XN, (const bf16*)(ws + WS_WQKV0), M, NQKV0, D, 0}; pg8::StaticOrder S; S.init(M, NQKV0, F.G, (int)blockIdx.x);
        pg8::EpiBf16<0> E{QB, D, nullptr, D, (size_t)(WS_K - WS_Q) / 2, attn_body::C2};
        pg8::gemm_phase<pg8::EpiBf16<0>, pg8::StaticOrder, PG8_ALIGN, PG8_SP2>(F.lds + RING_OFF, g, S, E);
    }
    GRID_BAR();

    {
        attn_body::lds_fptr tab = (attn_body::lds_fptr)(F.lds + NA_TAB_OFF);
        const int upc = (1024 + F.G - 1) / F.G; int cur_h = -1;
        for (int i = 0; i < upc; ++i) {
            const int id = F.vcu * upc + i; if (id >= 1024) break;
            const int bh = id >> 5, qb4 = id & 31, b = bh >> 4, h = bh & 15, r0 = 4 * qb4;
            if (h != cur_h) {
                const float* rp = args.in[I_RPB] + (size_t)h * 15 * 31;
                for (int u = F.tid; u < 15 * 128; u += NWAVES * 64) { const int ro = u >> 7, dc = (u & 127) - 64; const float v = (dc >= -15 && dc <= 15) ? rp[ro * 31 + dc + 15] * LOG2E : 0.f;
                    ((LAS float*)(F.lds + NA_TAB_OFF))[u] = v; }
                cur_h = h; LDS_WAIT(); __syncthreads();
            }
            int first = r0 - 4; first = first < 0 ? 0 : (first > 116 ? 116 : first);
            attn_body::attn_unit<1, 1024, 1024, 8>(b, h, h, 64 * r0, 64 * first, 12, (const attn_body::bf16*)QB, (const attn_body::bf16*)KB, (const attn_body::bf16*)VB, (attn_body::bf16*)QB, (char*)lds + RING_OFF, r0, first, tab);
        }
    }
    GRID_BAR();

    {
        pg8::Gemm g{QB, (const bf16*)(ws + WS_WO0), M, D, D, 0}; pg8::StaticOrder S; S.init(M, D, F.G, (int)blockIdx.x);
        pg8::EpiBf16<0> E{PO, D, nullptr, 0, 0, 1.f};
        pg8::gemm_phase<pg8::EpiBf16<0>, pg8::StaticOrder, PG8_ALIGN, PG8_SP2>(F.lds + RING_OFF, g, S, E);
    }
    GRID_BAR();

#define THIN_RES_NORM(HIN, GA, GB) do { \
        PHASE_IDS(); f32x4 ga[4], gb[4]; \
        _Pragma("unroll") for (int j = 0; j < 4; ++j) { ga[j] = *(const GAS f32x4*)((GA) + colb + 256 * j); gb[j] = *(const GAS f32x4*)((GB) + colb + 256 * j); } \
        for (int m = gw; m < M; m += NGW) { \
            f32x4 p[4], hv[4]; \
            _Pragma("unroll") for (int j = 0; j < 4; ++j) { p[j] = ld_bf16x4(PO + (size_t)m * D + colb + 256 * j); hv[j] = *(const GAS f32x4*)((HIN) + (size_t)m * D + colb + 256 * j); } \
            const float r1 = rms_scale(ssq4(p), D); \
            _Pragma("unroll") for (int j = 0; j < 4; ++j) { hv[j] = hv[j] + p[j] * r1 * ga[j]; *(GAS f32x4*)(out + (size_t)m * D + colb + 256 * j) = hv[j]; } \
            const float r2 = rms_scale(ssq4(hv), D); \
            _Pragma("unroll") for (int j = 0; j < 4; ++j) st_bf16x4(XN + (size_t)m * D + colb + 256 * j, hv[j] * r2 * gb[j]); \
        } } while (0)

    THIN_RES_NORM(x, norm_g + 1 * D, norm_g + 2 * D);
    GRID_BAR();

    {
        pg8::Gemm g{XN, (const bf16*)(ws + WS_WGU0), M, 2 * FF, D, 0}; pg8::StaticOrder S; S.init(M, 2 * FF, F.G, (int)blockIdx.x);
        pg8::EpiSwiglu E{ACT, FF};
        pg8::gemm_phase<pg8::EpiSwiglu, pg8::StaticOrder, PG8_ALIGN, PG8_SP2>(F.lds + RING_OFF, g, S, E);
    }
    GRID_BAR();

    {
        pg8::Gemm g{ACT, (const bf16*)(ws + WS_WD0), M, D, FF, 0}; pg8::StaticOrder S; S.init(M, D, F.G, (int)blockIdx.x);
        pg8::EpiBf16<0> E{PO, D, nullptr, 0, 0, 1.f};
        pg8::gemm_phase<pg8::EpiBf16<0>, pg8::StaticOrder, PG8_ALIGN, PG8_SP2>(F.lds + RING_OFF, g, S, E);
    }
    GRID_BAR();

    THIN_RES_NORM(out, norm_g + 3 * D, norm_g + 4 * D);
    GRID_BAR();

    {
        pg8::Gemm g{XN, (const bf16*)(ws + WS_WQKV1), M, NQKV1, D, 0}; pg8::StaticOrder S; S.init(M, NQKV1, F.G, (int)blockIdx.x);
        pg8::EpiQkvGqa E{QB, (size_t)(WS_K - WS_Q) / 2};
        pg8::gemm_phase<pg8::EpiQkvGqa, pg8::StaticOrder, PG8_ALIGN, PG8_SP2>(F.lds + RING_OFF, g, S, E);
    }
    GRID_BAR();

    {
        PHASE_IDS();
        const int j = lane & 15, hsub = lane >> 4, qtr = j >> 2;
        const f32x4 gq = *(const GAS f32x4*)(args.in[I_QN] + 4 * j), gk = *(const GAS f32x4*)(args.in[I_KN] + 4 * j);
        for (int m = gw; m < M; m += NGW) {
            const int t = m & (SEQ - 1), pos = (qtr < 2) ? (t >> 6) : (t & 63);
            const f32x4 c01 = *(const GAS f32x4*)(rope_tab + (pos * 16 + 4 * (j & 3)) * 2), c23 = *(const GAS f32x4*)(rope_tab + (pos * 16 + 4 * (j & 3)) * 2 + 4);
            const f32x4 cs = (f32x4){c01.x, c01.z, c23.x, c23.z}, sn = (f32x4){c01.y, c01.w, c23.y, c23.w};
#pragma unroll
            for (int ps = 0; ps < 5; ++ps) {
                bf16* p = ps < 4 ? QB + (size_t)m * D + (4 * ps + hsub) * HD + 4 * j : KB + (size_t)m * NKV + hsub * HD + 4 * j;
                f32x4 v = ld_bf16x4(p);
                float ss = (v.x * v.x + v.y * v.y) + (v.z * v.z + v.w * v.w);
                ss += __shfl_xor(ss, 1); ss += __shfl_xor(ss, 2); ss += __shfl_xor(ss, 4); ss += __shfl_xor(ss, 8);
                const float rn = rms_scale(ss, HD);
                v = v * rn * (ps < 4 ? gq : gk);
                f32x4 o; o.x = __shfl_xor(v.x, 4); o.y = __shfl_xor(v.y, 4); o.z = __shfl_xor(v.z, 4); o.w = __shfl_xor(v.w, 4);
                const f32x4 sgn = (qtr & 1) ? sn : -sn;
                f32x4 r = v * cs + o * sgn;
                if (ps < 4) r = r * attn_body::C2;
                st_bf16x4(p, r);
            }
        }
    }
    GRID_BAR();

    {
        const int upc = (1024 + F.G - 1) / F.G;
        for (int i = 0; i < upc; ++i) {
            const int id = F.vcu * upc + i; if (id >= 1024) break;
            const int bk = id >> 7, loc = id & 127, b = bk >> 2, hk = bk & 3, hq = 4 * hk + (loc >> 5), qb = loc & 31;
            attn_body::attn_unit<0, 1024, 256, 8>(b, hq, hk, 256 * qb, 0, SEQ / 64, (const attn_body::bf16*)QB, (const attn_body::bf16*)KB, (const attn_body::bf16*)VB, (attn_body::bf16*)QB, (char*)lds + RING_OFF, 0, 0, (attn_body::lds_fptr)(F.lds + NA_TAB_OFF));
        }
    }
    GRID_BAR();

    {
        pg8::Gemm g{QB, (const bf16*)(ws + WS_WO1), M, D, D, 0}; pg8::StaticOrder S; S.init(M, D, F.G, (int)blockIdx.x);
        pg8::EpiBf16<0> E{PO, D, nullptr, 0, 0, 1.f};
        pg8::gemm_phase<pg8::EpiBf16<0>, pg8::StaticOrder, PG8_ALIGN, PG8_SP2>(F.lds + RING_OFF, g, S, E);
    }
    GRID_BAR();

    {
        PHASE_IDS();
        LAS float* wrT = (LAS float*)(F.lds + RING_OFF);
        for (int u = F.tid; u < D * NE; u += NWAVES * 64) wrT[(u & 7) * D + (u >> 3)] = args.in[I_RT][u];
        f32x4 ga[4], gb[4];
#pragma unroll
        for (int j = 0; j < 4; ++j) { ga[j] = *(const GAS f32x4*)(norm_g + 5 * D + colb + 256 * j); gb[j] = *(const GAS f32x4*)(norm_g + 6 * D + colb + 256 * j); }
        LDS_WAIT(); __syncthreads();
        for (int c = (int)blockIdx.x; c < NCHUNK; c += F.G) {
            if (F.tid < NE) F.MISC[MW_CNT + F.tid] = 0u;
            __syncthreads();
            for (int i = 0; i < 8; ++i) {
                const int m = 64 * c + 8 * wave + i;
                f32x4 p[4], hv[4];
#pragma unroll
                for (int j = 0; j < 4; ++j) { p[j] = ld_bf16x4(PO + (size_t)m * D + colb + 256 * j); hv[j] = *(const GAS f32x4*)(out + (size_t)m * D + colb + 256 * j); }
                const float r1 = rms_scale(ssq4(p), D);
#pragma unroll
                for (int j = 0; j < 4; ++j) { hv[j] = hv[j] + p[j] * r1 * ga[j]; *(GAS f32x4*)(out + (size_t)m * D + colb + 256 * j) = hv[j]; }
                const float r2 = rms_scale(ssq4(hv), D);
#pragma unroll
                for (int j = 0; j < 4; ++j) { hv[j] = hv[j] * r2 * gb[j]; st_bf16x4(XN + (size_t)m * D + colb + 256 * j, hv[j]); }
                float lg[NE];
#pragma unroll
                for (int e = 0; e < NE; ++e) { float a = 0.f;
#pragma unroll
                    for (int j = 0; j < 4; ++j) { const f32x4 w = *(const LAS f32x4*)(wrT + e * D + colb + 256 * j); a += (hv[j].x * w.x + hv[j].y * w.y) + (hv[j].z * w.z + hv[j].w * w.w); }
                    lg[e] = wave_sum(a); }
                int e0 = 0; float v0 = lg[0];
#pragma unroll
                for (int e = 1; e < NE; ++e) if (lg[e] > v0) { v0 = lg[e]; e0 = e; }
                int e1 = -1; float v1 = -3.0e38f;
#pragma unroll
                for (int e = 0; e < NE; ++e) if (e != e0 && lg[e] > v1) { v1 = lg[e]; e1 = e; }
                if (e1 < 0) e1 = (e0 + 1) & 7;
                const float g0 = 1.0f / (1.0f + __expf(v1 - v0)), g1 = 1.0f - g0;
                if (lane == 0) { tok_e[2 * m] = e0; tok_e[2 * m + 1] = e1; tok_g[2 * m] = g0; tok_g[2 * m + 1] = g1;
                    __hip_atomic_fetch_add((LAS unsigned*)(F.lds + LDSCTL_OFF) + MW_CNT + e0, 1u, __ATOMIC_RELAXED, __HIP_MEMORY_SCOPE_WORKGROUP);
                    __hip_atomic_fetch_add((LAS unsigned*)(F.lds + LDSCTL_OFF) + MW_CNT + e1, 1u, __ATOMIC_RELAXED, __HIP_MEMORY_SCOPE_WORKGROUP); }
            }
            LDS_WAIT(); __syncthreads();
            if (F.tid < NE) ccnt[c * NE + F.tid] = (int)F.MISC[MW_CNT + F.tid];
            __syncthreads();
        }
    }
    GRID_BAR();

    {
        PHASE_IDS();
        LAS int* cn = (LAS int*)(F.lds + RING_OFF);
        LAS int* ps = cn + NCHUNK * NE;
        LAS int* pre = ps + 64 * NE;
        LAS int* tot = pre + 64 * NE;
        LAS int* rst = tot + NE;
        LAS int* ent = rst + NE;
        LAS int* slt = ent + 128;
        for (int u = F.tid; u < NCHUNK * NE; u += NWAVES * 64) cn[u] = ccnt[u];
        LDS_WAIT(); __syncthreads();
        { const int e = F.tid & 7, part = F.tid >> 3; ps[part * NE + e] = (cn[(4 * part + 0) * NE + e] + cn[(4 * part + 1) * NE + e]) + (cn[(4 * part + 2) * NE + e] + cn[(4 * part + 3) * NE + e]); }
        LDS_WAIT(); __syncthreads();
        if (F.tid < NE) { int run = 0; for (int part = 0; part < 64; ++part) { pre[part * NE + F.tid] = run; run += ps[part * NE + F.tid]; } tot[F.tid] = run; }
        LDS_WAIT(); __syncthreads();
        if (F.tid == 0) { int ts = 0; for (int e = 0; e < NE; ++e) { F.MISC[MW_TS + e] = (unsigned)ts; rst[e] = ts * 256; ts += (tot[e] + 255) >> 8; } F.MISC[MW_TS + NE] = (unsigned)ts; }
        LDS_WAIT(); __syncthreads();
        for (int c = (int)blockIdx.x; c < NCHUNK; c += F.G) {
            if (F.tid < 128) ent[F.tid] = tok_e[128 * c + F.tid];
            LDS_WAIT(); __syncthreads();
            if (F.tid < 128) { const int e = ent[F.tid]; int rank = 0; for (int q = 0; q < F.tid; ++q) rank += (ent[q] == e) ? 1 : 0;
                int base = rst[e] + pre[(c >> 2) * NE + e]; for (int q = 4 * (c >> 2); q < c; ++q) base += cn[q * NE + e];
                slt[F.tid] = base + rank; slot_of[128 * c + F.tid] = base + rank; }
            LDS_WAIT(); __syncthreads();
            for (int i = 0; i < 8; ++i) { const int rr = 8 * wave + i, m = 64 * c + rr; const int s0 = slt[2 * rr], s1 = slt[2 * rr + 1];
                const v4u a = *(const GAS v4u*)(XN + (size_t)m * D + 8 * lane), b2 = *(const GAS v4u*)(XN + (size_t)m * D + 512 + 8 * lane);
                *(GAS v4u*)(APERM + (size_t)s0 * D + 8 * lane) = a; *(GAS v4u*)(APERM + (size_t)s0 * D + 512 + 8 * lane) = b2;
                *(GAS v4u*)(APERM + (size_t)s1 * D + 8 * lane) = a; *(GAS v4u*)(APERM + (size_t)s1 * D + 512 + 8 * lane) = b2; }
            LDS_WAIT(); __syncthreads();
        }
    }
    GRID_BAR();

    {
        const int ntile = (int)F.MISC[MW_TS + NE];
        pg8::Gemm g{APERM, (const bf16*)(ws + WS_WGUM), ntile * 256, 2 * FF, D, (size_t)2 * FF * D * 2}; pg8::MoeOrder S; S.init(ntile * 256, 2 * FF, F.G, (int)blockIdx.x); S.ts = (const volatile LAS int*)(F.MISC + MW_TS);
        pg8::EpiSwiglu E{MACT, FF};
        pg8::gemm_phase<pg8::EpiSwiglu, pg8::MoeOrder, PG8_ALIGN, PG8_SP2>(F.lds + RING_OFF, g, S, E);
    }
    GRID_BAR();

    {
        PHASE_IDS();
        LAS float* scr = (LAS float*)(F.lds + RING_OFF + wave * SCR_WAVE);
        constexpr int I_F = 56 * 16;
        for (int it = gw; it < NE * I_F; it += NGW) { const int e = it / I_F;
            tr_matrix_item(args.in[I_MD] + (size_t)e * FF * D, FF, D, (bf16*)(ws + WS_WDM) + (size_t)e * D * FF, 0, it % I_F, scr, lane); }
    }
    GRID_BAR();

    {
        const int ntile = (int)F.MISC[MW_TS + NE];
        pg8::Gemm g{MACT, (const bf16*)(ws + WS_WDM), ntile * 256, D, FF, (size_t)D * FF * 2}; pg8::MoeOrder S; S.init(ntile * 256, D, F.G, (int)blockIdx.x); S.ts = (const volatile LAS int*)(F.MISC + MW_TS);
        pg8::EpiBf16<0> E{YB, D, nullptr, 0, 0, 1.f};
        pg8::gemm_phase<pg8::EpiBf16<0>, pg8::MoeOrder, PG8_ALIGN, PG8_SP2>(F.lds + RING_OFF, g, S, E);
    }
    GRID_BAR();

    {
        PHASE_IDS();
        f32x4 ga[4];
#pragma unroll
        for (int j = 0; j < 4; ++j) ga[j] = *(const GAS f32x4*)(norm_g + 7 * D + colb + 256 * j);
        const unsigned bad = __hip_atomic_load((gu32*)((unsigned*)(F.ctl + CW_BAR) + XB_TMO), RLX_AGENT);
        for (int m = gw; m < M; m += NGW) {
            const int s0 = slot_of[2 * m], s1 = slot_of[2 * m + 1]; const float g0 = tok_g[2 * m], g1 = tok_g[2 * m + 1];
            f32x4 y[4], hv[4];
#pragma unroll
            for (int j = 0; j < 4; ++j) { y[j] = ld_bf16x4(YB + (size_t)s0 * D + colb + 256 * j) * g0 + ld_bf16x4(YB + (size_t)s1 * D + colb + 256 * j) * g1; hv[j] = *(const GAS f32x4*)(out + (size_t)m * D + colb + 256 * j); }
            const float r = rms_scale(ssq4(y), D);
            const float qn = bad ? __builtin_nanf("") : 0.f;
#pragma unroll
            for (int j = 0; j < 4; ++j) *(GAS f32x4*)(out + (size_t)m * D + colb + 256 * j) = hv[j] + y[j] * r * ga[j] + qn;
        }
    }
#undef GRID_BAR
#undef THIN_RES_NORM
}

extern "C" void kernel_launch(void* const* d_in, const int* in_sizes, int n_in, void* d_out, int out_size, void* d_ws, size_t ws_size, hipStream_t stream) {
    static int grid = 0;
    if (grid == 0) {
        if (n_in != 16 || in_sizes[0] != M * D || out_size != M * D || ws_size < WS_END) { fprintf(stderr, "kernel_launch: built for 16 inputs, x and out of %d floats, >= %zu bytes of workspace; got n_in %d, in0 %d, out %d, ws %zu; nothing launched\n", M * D, (size_t)WS_END, n_in, n_in > 0 ? in_sizes[0] : -1, out_size, ws_size); grid = -1; return; }
        int dev = 0, cus = 0, per_cu = 0;
        if (hipGetDevice(&dev) != hipSuccess || hipDeviceGetAttribute(&cus, hipDeviceAttributeMultiprocessorCount, dev) != hipSuccess) { fprintf(stderr, "kernel_launch: hipGetDevice / hipDeviceGetAttribute failed; nothing launched\n"); grid = -1; return; }
        if (hipFuncSetAttribute((const void*)fwd_kernel, hipFuncAttributeMaxDynamicSharedMemorySize, LDS_BYTES) != hipSuccess) { fprintf(stderr, "kernel_launch: hipFuncSetAttribute failed (%d bytes of dynamic LDS); nothing launched\n", LDS_BYTES); grid = -1; return; }
        if (hipOccupancyMaxActiveBlocksPerMultiprocessor(&per_cu, (const void*)fwd_kernel, NWAVES * 64, LDS_BYTES) != hipSuccess || per_cu < 1) { fprintf(stderr, "kernel_launch: occupancy query reports %d workgroups per CU; nothing launched\n", per_cu); (void)hipGetLastError(); grid = -1; return; }
        grid = cus;
    }
    if (grid < 0) return;
    if (hipMemsetAsync((char*)d_ws + WS_CTL, 0, CTL_ZERO_BYTES, stream) != hipSuccess) { fprintf(stderr, "kernel_launch: hipMemsetAsync of the control words failed; nothing launched\n"); return; }
    Args a{};
    for (int i = 0; i < 16; ++i) a.in[i] = (const float*)d_in[i];
    a.out = (float*)d_out; a.ws = (unsigned char*)d_ws;
    hipLaunchKernelGGL(fwd_kernel, dim3(grid), dim3(NWAVES * 64), LDS_BYTES, stream, a);
    const hipError_t le = hipPeekAtLastError();
    if (le != hipSuccess) fprintf(stderr, "kernel_launch: launch failed: %s (grid %d x %d threads, %d B LDS)\n", hipGetErrorName(le), grid, NWAVES * 64, LDS_BYTES);
}
```

```cpp
#include <hip/hip_runtime.h>
#include <cstdio>
#include <cstdint>
namespace pg8 {
#define PG8_LAS __attribute__((address_space(3)))
typedef unsigned short bf16_t;
typedef short bf16x8 __attribute__((ext_vector_type(8)));
typedef float f32x4 __attribute__((ext_vector_type(4)));
typedef unsigned u32x4 __attribute__((ext_vector_type(4)));
typedef int i32x4 __attribute__((ext_vector_type(4)));
typedef int i32x8 __attribute__((ext_vector_type(8)));
typedef unsigned u32x2 __attribute__((ext_vector_type(2)));
constexpr int BM = 256, BK = 64, HALF = 128, HTB = HALF * BK * 2  , STAGE_BYTES = 8 * HTB, NXCD = 8, WGM = 8;

__host__ __device__ __forceinline__ int lds_byte(int r, int c) { const int st = (r >> 4) * 2 + (c >> 5), rr = r & 15, cc = c & 31, ob = rr * 64 + cc * 2; return st * 1024 + (ob ^ (((ob >> 9) & 1) << 5)); }
__host__ __device__ __forceinline__ void stage_rc(int b, int& R, int& C) { const int st = b / 1024, sb = b % 1024, swz = sb ^ (((sb >> 9) & 1) << 5); R = (st >> 1) * 16 + swz / 64; C = (st & 1) * 32 + (swz % 64) / 2; }
__host__ __device__ __forceinline__ int perm32(int rho) { const int n = rho >> 4, i = rho & 15; return 8 * (i >> 2) + 4 * n + (i & 3); }

struct Unit { int pm, pn, eb, kb, po; };
struct Gemm { const bf16_t* A; const bf16_t* Bt; int M, N, K; size_t bstride; int ntk; };

struct StaticOrder {
    int nM, nN, nwg, G, c, nlim;
    __host__ __device__ void init(int M, int N, int G_, int c_) { nM = M / BM; nN = N / BM; nwg = nM * nN; G = G_; c = c_; nlim = nwg; }
    __host__ __device__ __forceinline__ bool next(int i, Unit& u) const { const long L = (long)i * G + c; if (L >= nlim) return false; at((int)L, u); return true; }
    __host__ __device__ __forceinline__ void at(int L, Unit& u) const {
        int wgid = L; { const int q = nwg / NXCD, r = nwg % NXCD, xcd = wgid % NXCD, off = wgid / NXCD; wgid = (xcd < r ? xcd * (q + 1) : r * (q + 1) + (xcd - r) * q) + off; }
        const int nig = WGM * nN, gid = wgid / nig, fm = gid * WGM, gsz = (nM - fm) < WGM ? (nM - fm) : WGM;
        u.pm = fm + ((wgid % nig) % gsz); u.pn = (wgid % nig) / gsz; u.eb = 0; u.kb = 0; u.po = 0;
    }
    __device__ __forceinline__ void a_ready(const Unit&) const {}
    __device__ __forceinline__ void done(const Unit&) const {}
};

__device__ __forceinline__ unsigned cvt_pk_bf16(float lo, float hi) { unsigned r; asm volatile("v_cvt_pk_bf16_f32 %0, %1, %2" : "=v"(r) : "v"(lo), "v"(hi)); return r; }
typedef float f32x2 __attribute__((ext_vector_type(2)));
__device__ __forceinline__ f32x2 gelu_pk(f32x2 v) {
    const f32x2 av = __builtin_elementwise_abs(v), d = av * 0.2316418882f + 1.0f;
    f32x2 t; t.x = __builtin_amdgcn_rcpf(d.x); t.y = __builtin_amdgcn_rcpf(d.y);
    f32x2 q = t * 0.5307027145f + (-0.7265760135f); q = q * t + 0.7107068705f; q = q * t + (-0.142248368f); q = q * t + 0.127414796f; q = q * t;
    const f32x2 s = (v * v) * (-0.72134752044f);
    f32x2 e; e.x = __builtin_amdgcn_exp2f(s.x); e.y = __builtin_amdgcn_exp2f(s.y);
    const f32x2 m = v * (q * e), r = v - m;
    f32x2 o; o.x = v.x < 0.f ? m.x : r.x; o.y = v.y < 0.f ? m.y : r.y; return o;
}

template <int ACT  > struct EpiBf16 {
    static constexpr bool PERM = true, AFTER_DRAIN = false; static_assert(ACT == 0 || ACT == 1, "EpiBf16: ACT is 0 (none) or 1 (gelu_pk)");
    bf16_t* O; int ldc; const float* bias; int split_cols; size_t split_stride; float scale0;
    __device__ __forceinline__ void operator()(const f32x4 (&acc)[2][2][4][2], const Unit& u, int wr, int wc, int fr, int fq) const {
        const int row0 = u.pm * BM + wr * 64 + fr; int colt = u.pn * BM; bf16_t* base = O;
        float sc = 1.f; if (split_cols) { const int t = colt / split_cols; base += (size_t)t * split_stride; colt -= t * split_cols; if (t == 0) sc = scale0; }
        const int col0 = colt + wc * 32 + 8 * fq, bcol0 = u.pn * BM + wc * 32 + 8 * fq;
        f32x4 bv[2][2];
#pragma unroll
        for (int bj = 0; bj < 2; ++bj)
#pragma unroll
            for (int n = 0; n < 2; ++n) bv[bj][n] = bias ? *(const f32x4*)(bias + bcol0 + bj * HALF + 4 * n) : (f32x4){0.f, 0.f, 0.f, 0.f};
#pragma unroll
        for (int ai = 0; ai < 2; ++ai)
#pragma unroll
            for (int m = 0; m < 4; ++m) { bf16_t* rowp = base + (size_t)(row0 + ai * HALF + m * 16) * ldc + col0;
#pragma unroll
                for (int bj = 0; bj < 2; ++bj) { f32x4 v0 = acc[ai][bj][m][0] + bv[bj][0], v1 = acc[ai][bj][m][1] + bv[bj][1];
                    if (ACT == 1) { f32x2 a = gelu_pk((f32x2){v0[0], v0[1]}), b = gelu_pk((f32x2){v0[2], v0[3]}), c = gelu_pk((f32x2){v1[0], v1[1]}), d = gelu_pk((f32x2){v1[2], v1[3]});
                        v0 = (f32x4){a.x, a.y, b.x, b.y}; v1 = (f32x4){c.x, c.y, d.x, d.y}; }
                    v0 = v0 * sc; v1 = v1 * sc; u32x4 w; w.x = cvt_pk_bf16(v0[0], v0[1]); w.y = cvt_pk_bf16(v0[2], v0[3]); w.z = cvt_pk_bf16(v1[0], v1[1]); w.w = cvt_pk_bf16(v1[2], v1[3]);
                    *(u32x4*)(rowp + bj * HALF) = w; } }
    }
};

struct EpiQkvRope {
    static constexpr bool PERM = true, AFTER_DRAIN = false;
    bf16_t* Q; size_t kv_stride; const float* qg; const float* kg; const float* rope; float qscale, eps;
    __device__ __forceinline__ void operator()(const f32x4 (&acc)[2][2][4][2], const Unit& u, int wr, int wc, int fr, int fq) const {
        const int row0 = u.pm * BM + wr * 64 + fr;
        if (u.pn == 5) {
            bf16_t* base = Q + 2 * kv_stride; const int col0 = wc * 32 + 8 * fq;
#pragma unroll
            for (int ai = 0; ai < 2; ++ai)
#pragma unroll
                for (int m = 0; m < 4; ++m) { bf16_t* rowp = base + (size_t)(row0 + ai * HALF + m * 16) * 256 + col0;
#pragma unroll
                    for (int bj = 0; bj < 2; ++bj) { const f32x4 v0 = acc[ai][bj][m][0], v1 = acc[ai][bj][m][1];
                        u32x4 w; w.x = cvt_pk_bf16(v0[0], v0[1]); w.y = cvt_pk_bf16(v0[2], v0[3]); w.z = cvt_pk_bf16(v1[0], v1[1]); w.w = cvt_pk_bf16(v1[2], v1[3]);
                        *(u32x4*)(rowp + bj * HALF) = w; } }
            return;
        }
        const bool isq = u.pn < 4;
        bf16_t* base = isq ? Q : Q + kv_stride; const int ldc = isq ? 1024 : 256, hcol = (isq ? u.pn * BM : 0) + wc * 64;
        const float* g = isq ? qg : kg; const float sc = isq ? qscale : 1.f;
        const int dlo = 8 * fq + (fq >= 2 ? 16 : 0), i0 = 8 * (fq & 1);
        const f32x4 g1a = *(const f32x4*)(g + dlo), g1b = *(const f32x4*)(g + dlo + 4), g2a = *(const f32x4*)(g + dlo + 16), g2b = *(const f32x4*)(g + dlo + 20);
#pragma unroll
        for (int ai = 0; ai < 2; ++ai)
#pragma unroll
            for (int m = 0; m < 4; ++m) {
                const int row = row0 + ai * HALF + m * 16, t = row & 8191, pos = fq < 2 ? (t >> 6) : (t & 63);
                const float* tp = rope + (size_t)(pos * 16 + i0) * 2;
                const f32x4 c0 = *(const f32x4*)tp, c1 = *(const f32x4*)(tp + 4), c2 = *(const f32x4*)(tp + 8), c3 = *(const f32x4*)(tp + 12);
                const f32x4 x1a = acc[ai][0][m][0], x1b = acc[ai][0][m][1], x2a = acc[ai][1][m][0], x2b = acc[ai][1][m][1];
                float ss = ((x1a[0] * x1a[0] + x1a[1] * x1a[1]) + (x1a[2] * x1a[2] + x1a[3] * x1a[3])) + ((x1b[0] * x1b[0] + x1b[1] * x1b[1]) + (x1b[2] * x1b[2] + x1b[3] * x1b[3]))
                         + ((x2a[0] * x2a[0] + x2a[1] * x2a[1]) + (x2a[2] * x2a[2] + x2a[3] * x2a[3])) + ((x2b[0] * x2b[0] + x2b[1] * x2b[1]) + (x2b[2] * x2b[2] + x2b[3] * x2b[3]));
                ss += __shfl_xor(ss, 16); ss += __shfl_xor(ss, 32);
                const float rn = sc / sqrtf(ss * (1.0f / 64.0f) + eps);
                const f32x4 y1a = x1a * g1a * rn, y1b = x1b * g1b * rn, y2a = x2a * g2a * rn, y2b = x2b * g2b * rn;
                const f32x4 csa = (f32x4){c0[0], c0[2], c1[0], c1[2]}, sna = (f32x4){c0[1], c0[3], c1[1], c1[3]}, csb = (f32x4){c2[0], c2[2], c3[0], c3[2]}, snb = (f32x4){c2[1], c2[3], c3[1], c3[3]};
                const f32x4 o1a = y1a * csa - y2a * sna, o1b = y1b * csb - y2b * snb, o2a = y2a * csa + y1a * sna, o2b = y2b * csb + y1b * snb;
                bf16_t* rowp = base + (size_t)row * ldc + hcol + dlo;
                u32x4 w1; w1.x = cvt_pk_bf16(o1a[0], o1a[1]); w1.y = cvt_pk_bf16(o1a[2], o1a[3]); w1.z = cvt_pk_bf16(o1b[0], o1b[1]); w1.w = cvt_pk_bf16(o1b[2], o1b[3]);
                u32x4 w2; w2.x = cvt_pk_bf16(o2a[0], o2a[1]); w2.y = cvt_pk_bf16(o2a[2], o2a[3]); w2.z = cvt_pk_bf16(o2b[0], o2b[1]); w2.w = cvt_pk_bf16(o2b[2], o2b[3]);
                *(u32x4*)rowp = w1; *(u32x4*)(rowp + 16) = w2; }
    }
};
__device__ __forceinline__ float silu_mul(float g, float u) { return g * __builtin_amdgcn_rcpf(1.0f + __builtin_amdgcn_exp2f(g * -1.4426950408889634f)) * u; }
struct EpiSwiglu {
    static constexpr bool PERM = true, AFTER_DRAIN = false;
    bf16_t* O; int ldc;
    __device__ __forceinline__ void operator()(const f32x4 (&acc)[2][2][4][2], const Unit& u, int wr, int wc, int fr, int fq) const {
        const int row0 = u.pm * BM + wr * 64 + fr, col0 = u.pn * HALF + wc * 32 + 8 * fq;
#pragma unroll
        for (int ai = 0; ai < 2; ++ai)
#pragma unroll
            for (int m = 0; m < 4; ++m) { bf16_t* rowp = O + (size_t)(row0 + ai * HALF + m * 16) * ldc + col0;
                const f32x4 g0 = acc[ai][0][m][0], g1 = acc[ai][0][m][1], u0 = acc[ai][1][m][0], u1 = acc[ai][1][m][1];
                u32x4 w; w.x = cvt_pk_bf16(silu_mul(g0[0], u0[0]), silu_mul(g0[1], u0[1])); w.y = cvt_pk_bf16(silu_mul(g0[2], u0[2]), silu_mul(g0[3], u0[3]));
                w.z = cvt_pk_bf16(silu_mul(g1[0], u1[0]), silu_mul(g1[1], u1[1])); w.w = cvt_pk_bf16(silu_mul(g1[2], u1[2]), silu_mul(g1[3], u1[3]));
                *(u32x4*)rowp = w; }
    }
};
__device__ __forceinline__ unsigned cvt4_fp8(float a, float b, float c, float d) {
    a = __builtin_fminf(__builtin_fmaxf(a, -448.f), 448.f); b = __builtin_fminf(__builtin_fmaxf(b, -448.f), 448.f); c = __builtin_fminf(__builtin_fmaxf(c, -448.f), 448.f); d = __builtin_fminf(__builtin_fmaxf(d, -448.f), 448.f);
    int w = 0; w = __builtin_amdgcn_cvt_pk_fp8_f32(a, b, w, false); w = __builtin_amdgcn_cvt_pk_fp8_f32(c, d, w, true); return (unsigned)w; }
struct EpiSwigluF8 {
    static constexpr bool PERM = true, AFTER_DRAIN = false;
    unsigned char* O; int ldc; float s;
    __device__ __forceinline__ void operator()(const f32x4 (&acc)[2][2][4][2], const Unit& u, int wr, int wc, int fr, int fq) const {
        const int row0 = u.pm * BM + wr * 64 + fr + 16 * (fq & 1), col0 = u.pn * HALF + wc * 32 + 16 * (fq >> 1);
        const float c1 = -1.4426950408889634f * s, is2 = 1.0f / (s * s);
#define PG8_SILU(G_, U_) (((G_) * (U_)) * __builtin_amdgcn_rcpf(__builtin_fmaf(__builtin_amdgcn_exp2f((G_) * c1), is2, is2)))
#pragma unroll
        for (int ai = 0; ai < 2; ++ai)
#pragma unroll
            for (int mp = 0; mp < 2; ++mp) { unsigned wx[2], wy[2];
#pragma unroll
                for (int q = 0; q < 2; ++q) { const int m = 2 * mp + q; const f32x4 g0 = acc[ai][0][m][0], g1 = acc[ai][0][m][1], u0 = acc[ai][1][m][0], u1 = acc[ai][1][m][1];
                    wx[q] = cvt4_fp8(PG8_SILU(g0[0], u0[0]), PG8_SILU(g0[1], u0[1]), PG8_SILU(g0[2], u0[2]), PG8_SILU(g0[3], u0[3]));
                    wy[q] = cvt4_fp8(PG8_SILU(g1[0], u1[0]), PG8_SILU(g1[1], u1[1]), PG8_SILU(g1[2], u1[2]), PG8_SILU(g1[3], u1[3])); }
                const auto sx = __builtin_amdgcn_permlane16_swap(wx[0], wx[1], false, false), sy = __builtin_amdgcn_permlane16_swap(wy[0], wy[1], false, false);
                u32x4 w; w.x = sx[0]; w.y = sy[0]; w.z = sx[1]; w.w = sy[1];
                *(u32x4*)(O + (size_t)(row0 + ai * HALF + mp * 32) * ldc + col0) = w; }
#undef PG8_SILU
    }
};
struct EpiF8Scale {
    static constexpr bool PERM = true, AFTER_DRAIN = false;
    unsigned char* O; int ldc; float s;
    __device__ __forceinline__ void operator()(const f32x4 (&acc)[2][2][4][2], const Unit& u, int wr, int wc, int fr, int fq) const {
        int fr_ = fr, fq_ = fq; asm volatile("" : "+v"(fr_), "+v"(fq_));
        const int row0 = u.pm * BM + wr * 64 + fr_ + 16 * (fq_ & 1), col0 = u.pn * BM + wc * 32 + 16 * (fq_ >> 1);
#pragma unroll
        for (int ai = 0; ai < 2; ++ai)
#pragma unroll
            for (int mp = 0; mp < 2; ++mp)
#pragma unroll
                for (int bj = 0; bj < 2; ++bj) { unsigned wx[2], wy[2];
#pragma unroll
                    for (int q = 0; q < 2; ++q) { const int m = 2 * mp + q; const f32x4 v0 = acc[ai][bj][m][0] * s, v1 = acc[ai][bj][m][1] * s;
                        wx[q] = cvt4_fp8(v0[0], v0[1], v0[2], v0[3]); wy[q] = cvt4_fp8(v1[0], v1[1], v1[2], v1[3]); }
                    const auto sx = __builtin_amdgcn_permlane16_swap(wx[0], wx[1], false, false), sy = __builtin_amdgcn_permlane16_swap(wy[0], wy[1], false, false);
                    u32x4 w; w.x = sx[0]; w.y = sy[0]; w.z = sx[1]; w.w = sy[1];
                    *(u32x4*)(O + (size_t)(row0 + ai * HALF + mp * 32) * ldc + col0 + bj * HALF) = w; }
    }
};
struct EpiBf16Scale {
    static constexpr bool PERM = true, AFTER_DRAIN = false;
    bf16_t* O; int ldc; float s;
    __device__ __forceinline__ void operator()(const f32x4 (&acc)[2][2][4][2], const Unit& u, int wr, int wc, int fr, int fq) const {
        const int row0 = u.pm * BM + wr * 64 + fr, col0 = u.pn * BM + wc * 32 + 8 * fq;
#pragma unroll
        for (int ai = 0; ai < 2; ++ai)
#pragma unroll
            for (int m = 0; m < 4; ++m) { bf16_t* rowp = O + (size_t)(row0 + ai * HALF + m * 16) * ldc + col0;
#pragma unroll
                for (int bj = 0; bj < 2; ++bj) { const f32x4 v0 = acc[ai][bj][m][0] * s, v1 = acc[ai][bj][m][1] * s;
                    u32x4 w; w.x = cvt_pk_bf16(v0[0], v0[1]); w.y = cvt_pk_bf16(v0[2], v0[3]); w.z = cvt_pk_bf16(v1[0], v1[1]); w.w = cvt_pk_bf16(v1[2], v1[3]);
                    *(u32x4*)(rowp + bj * HALF) = w; } }
    }
};
struct EpiNull {
    static constexpr bool PERM = true, AFTER_DRAIN = false;
    float* sink;
    __device__ __forceinline__ void operator()(const f32x4 (&acc)[2][2][4][2], const Unit& u, int wr, int wc, int fr, int fq) const {
        f32x4 s = acc[0][0][0][0];
#pragma unroll
        for (int ai = 0; ai < 2; ++ai)
#pragma unroll
            for (int bj = 0; bj < 2; ++bj)
#pragma unroll
                for (int m = 0; m < 4; ++m)
#pragma unroll
                    for (int n = 0; n < 2; ++n) s += acc[ai][bj][m][n];
        if (s[0] + s[1] + s[2] + s[3] == 1.2345e-30f) sink[0] = s[0];
    }
};
struct MoeOrder : StaticOrder {
    const volatile PG8_LAS int* ts;
    __device__ __forceinline__ void expert_of(Unit& u) const { int e = 0;
#pragma unroll
        for (int j = 1; j < 8; ++j) e += (u.pm >= ts[j]) ? 1 : 0;
        u.eb = __builtin_amdgcn_readfirstlane(e); }
    __device__ __forceinline__ bool next(int i, Unit& u) const { if (!StaticOrder::next(i, u)) return false; expert_of(u); return true; }
    __device__ __forceinline__ void at(int L, Unit& u) const { StaticOrder::at(L, u); expert_of(u); }
};
struct SplitKOrder : MoeOrder { int pm0, KS, kpart, ntot;
    __device__ __forceinline__ bool next(int i, Unit& u) const { const int L = i * G + c; if (L >= ntot) return false; const int ui = L / KS; u.pm = pm0 + ui / nN; u.pn = ui % nN; expert_of(u); u.kb = (L % KS) * kpart; u.po = L; return true; }
};
struct EpiBf16Part {
    static constexpr bool PERM = true, AFTER_DRAIN = false;
    bf16_t* O; float s;
    __device__ __forceinline__ void operator()(const f32x4 (&acc)[2][2][4][2], const Unit& u, int wr, int wc, int fr, int fq) const {
        int fr_ = fr, fq_ = fq; asm volatile("" : "+v"(fr_), "+v"(fq_));
        const int row0 = wr * 64 + fr_, col0 = wc * 32 + 8 * fq_; bf16_t* const T = O + (size_t)u.po * (BM * BM);
#pragma unroll
        for (int ai = 0; ai < 2; ++ai)
#pragma unroll
            for (int m = 0; m < 4; ++m) { bf16_t* rowp = T + (size_t)(row0 + ai * HALF + m * 16) * BM + col0;
#pragma unroll
                for (int bj = 0; bj < 2; ++bj) { const f32x4 v0 = acc[ai][bj][m][0] * s, v1 = acc[ai][bj][m][1] * s;
                    u32x4 w; w.x = cvt_pk_bf16(v0[0], v0[1]); w.y = cvt_pk_bf16(v0[2], v0[3]); w.z = cvt_pk_bf16(v1[0], v1[1]); w.w = cvt_pk_bf16(v1[2], v1[3]);
                    *(u32x4*)(rowp + bj * HALF) = w; } }
    }
};
struct OneUnit { Unit u{};
    __device__ __forceinline__ bool next(int i, Unit& o) const { if (i != 0) return false; o = u; return true; }
    __device__ __forceinline__ void a_ready(const Unit&) const {}
    __device__ __forceinline__ void done(const Unit&) const {}
};
template <class Epi, class Sched, bool ALIGN_EPI = false, bool SP2 = false, bool F8 = false>
__device__ __forceinline__ void gemm_phase(PG8_LAS unsigned char* lds, const Gemm g, const Sched& S, const Epi& E) {
    int tid_ = threadIdx.x; asm volatile("" : "+v"(tid_));
    const int tid = tid_, wid = __builtin_amdgcn_readfirstlane(tid >> 6), lane = tid & 63, wr = wid >> 2, wc = wid & 3, fr = lane & 15, fq = lane >> 4;
    const int K = g.K, nt = g.ntk ? g.ntk : K / BK;
    unsigned voffA[2], voffB[2];
#pragma unroll
    for (int i = 0; i < 2; ++i) { int R, C; stage_rc(tid * 16 + i * 8192, R, C); const int Rb = Epi::PERM ? ((R & ~31) + perm32(R & 31)) : R;
        voffA[i] = (unsigned)(R * K + C) * 2u; voffB[i] = (unsigned)(Rb * K + C) * 2u; }
    const size_t kstep = (size_t)(BK * 2);
    const size_t hstep = (size_t)HALF * K * 2;
    const size_t tstep = 2 * hstep;
    const unsigned ldsw = (unsigned)wid * 1024u;
    const int aoff = lds_byte(wr * 64 + fr, fq * 8), boff = lds_byte(wc * 32 + fr, fq * 8);
#define PG8_SA(b, h) (((b) * 2 + (h)) * HTB)
#define PG8_SB(b, h) ((4 + (b) * 2 + (h)) * HTB)
#define PG8_STAGE(bufoff, gbase, voff) do { _Pragma("unroll") for (int _i = 0; _i < 2; ++_i) \
        __builtin_amdgcn_global_load_lds((const unsigned*)((const char*)(gbase) + (voff)[_i]), (PG8_LAS unsigned*)(lds + (bufoff) + ldsw + _i * 8192), 16, 0, 0); } while (0)
#define PG8_RD16(off) (*(const PG8_LAS i32x4*)(lds + (off)))
#define PG8_CAT(x, y) __builtin_shufflevector((x), (y), 0, 1, 2, 3, 4, 5, 6, 7)
#define PG8_LDA(dst, b, h) do { _Pragma("unroll") for (int m = 0; m < 4; ++m) { if constexpr (F8) dst##8[m] = PG8_CAT(PG8_RD16(PG8_SA(b, h) + aoff + m * 2048), PG8_RD16(PG8_SA(b, h) + aoff + m * 2048 + 1024)); \
        else { _Pragma("unroll") for (int k = 0; k < 2; ++k) dst[m][k] = *(const PG8_LAS bf16x8*)(lds + PG8_SA(b, h) + aoff + m * 2048 + k * 1024); } } } while (0)
#define PG8_LDB(dst, b, h) do { _Pragma("unroll") for (int n = 0; n < 2; ++n) { if constexpr (F8) dst##8[n] = PG8_CAT(PG8_RD16(PG8_SB(b, h) + boff + n * 2048), PG8_RD16(PG8_SB(b, h) + boff + n * 2048 + 1024)); \
        else { _Pragma("unroll") for (int k = 0; k < 2; ++k) dst[n][k] = *(const PG8_LAS bf16x8*)(lds + PG8_SB(b, h) + boff + n * 2048 + k * 1024); } } } while (0)
#define PG8_MMA(ai, bj, At, Bt) do { __builtin_amdgcn_s_setprio(1); _Pragma("unroll") for (int m = 0; m < 4; ++m) _Pragma("unroll") for (int n = 0; n < 2; ++n) { \
        if constexpr (F8) asm volatile("v_mfma_f32_16x16x128_f8f6f4 %0, %1, %2, %0" : "+v"(acc[ai][bj][m][n]) : "v"(Bt##8[n]), "v"(At##8[m]));   \
        else { _Pragma("unroll") for (int k = 0; k < 2; ++k) acc[ai][bj][m][n] = __builtin_amdgcn_mfma_f32_16x16x32_bf16(Bt[n][k], At[m][k], acc[ai][bj][m][n], 0, 0, 0); } } \
        __builtin_amdgcn_s_setprio(0); } while (0)
#define PG8_WAIT_V(n) asm volatile("s_waitcnt vmcnt(" #n ")" ::: "memory")
#define PG8_WAIT_L(n) asm volatile("s_waitcnt lgkmcnt(" #n ")" ::: "memory")
#define PG8_BAR __builtin_amdgcn_s_barrier()
#define PG8_SCHED __builtin_amdgcn_sched_barrier(0)
    Unit cur, nxt; int ui = 0;
    if (!S.next(0, cur)) return;
    f32x4 acc[2][2][4][2];
#pragma unroll
    for (int a = 0; a < 2; ++a)
#pragma unroll
        for (int b = 0; b < 2; ++b)
#pragma unroll
            for (int m = 0; m < 4; ++m)
#pragma unroll
                for (int n = 0; n < 2; ++n) { f32x4 z_ = (f32x4){0.f, 0.f, 0.f, 0.f}; asm volatile("" : "+v"(z_)); acc[a][b][m][n] = z_; }
    bf16x8 At[4][2], B0[2][2], B1[2][2]; i32x8 At8[4], B08[2], B18[2];
    const char* cA = (const char*)g.A + (size_t)cur.pm * tstep + cur.kb; const char* cB = (const char*)g.Bt + (size_t)cur.eb * g.bstride + (size_t)cur.pn * tstep + cur.kb;
    S.a_ready(cur);
    if constexpr (SP2) {
        PG8_STAGE(PG8_SB(0, 0), cB, voffB); PG8_STAGE(PG8_SB(0, 1), cB + hstep, voffB); PG8_STAGE(PG8_SA(0, 0), cA, voffA); PG8_STAGE(PG8_SA(0, 1), cA + hstep, voffA);
        if (wr == 1) PG8_BAR;
        PG8_WAIT_V(2); PG8_BAR;
        PG8_STAGE(PG8_SB(1, 0), cB + kstep, voffB); PG8_STAGE(PG8_SA(1, 0), cA + kstep, voffA); PG8_STAGE(PG8_SB(1, 1), cB + hstep + kstep, voffB);
        PG8_WAIT_V(6); PG8_BAR;
    } else {
        PG8_STAGE(PG8_SB(0, 0), cB, voffB); PG8_STAGE(PG8_SA(0, 0), cA, voffA); PG8_STAGE(PG8_SB(0, 1), cB + hstep, voffB); PG8_STAGE(PG8_SA(0, 1), cA + hstep, voffA);
        if (wr == 1) PG8_BAR;
        PG8_WAIT_V(4); PG8_BAR;
        PG8_STAGE(PG8_SB(1, 0), cB + kstep, voffB); PG8_STAGE(PG8_SA(1, 0), cA + kstep, voffA); PG8_STAGE(PG8_SB(1, 1), cB + hstep + kstep, voffB);
        PG8_WAIT_V(6); PG8_BAR;
    }
    for (;;) {
        const bool has_next = S.next(ui + 1, nxt);
        const char* nA = has_next ? (const char*)g.A + (size_t)nxt.pm * tstep + nxt.kb : cA; const char* nB = has_next ? (const char*)g.Bt + (size_t)nxt.eb * g.bstride + (size_t)nxt.pn * tstep + nxt.kb : cB;
        asm volatile(".p2align 6");
        _Pragma("nounroll") for (int t = 0; t < nt; t += 2) {
            const bool last = (t == nt - 2);
            const char* a1 = cA + (size_t)(t + 1) * kstep;
            const char* a2 = last ? nA : cA + (size_t)(t + 2) * kstep; const char* b2 = last ? nB : cB + (size_t)(t + 2) * kstep;
            const char* a3 = a2 + kstep; const char* b3 = b2 + kstep;
            if (last && has_next) S.a_ready(nxt);
            if constexpr (SP2) {
            PG8_LDB(B0, 0, 0); PG8_LDB(B1, 0, 1); PG8_SCHED; PG8_LDA(At, 0, 0); PG8_STAGE(PG8_SA(1, 1), a1 + hstep, voffA);
            PG8_WAIT_V(8); PG8_WAIT_L(0); PG8_BAR; PG8_MMA(0, 0, At, B0); PG8_MMA(0, 1, At, B1); PG8_BAR; PG8_SCHED;
            PG8_LDA(At, 0, 1); PG8_STAGE(PG8_SB(0, 0), b2, voffB); PG8_STAGE(PG8_SB(0, 1), b2 + hstep, voffB); PG8_STAGE(PG8_SA(0, 0), a2, voffA);
            PG8_WAIT_V(8); PG8_WAIT_L(0); PG8_BAR; PG8_MMA(1, 0, At, B0); PG8_MMA(1, 1, At, B1); PG8_BAR; PG8_SCHED;
            PG8_LDB(B0, 1, 0); PG8_LDB(B1, 1, 1); PG8_SCHED; PG8_LDA(At, 1, 0); PG8_STAGE(PG8_SA(0, 1), a2 + hstep, voffA);
            PG8_WAIT_V(8); PG8_WAIT_L(0); PG8_BAR; PG8_MMA(0, 0, At, B0); PG8_MMA(0, 1, At, B1); PG8_BAR; PG8_SCHED;
            PG8_LDA(At, 1, 1); PG8_STAGE(PG8_SB(1, 0), b3, voffB); PG8_STAGE(PG8_SB(1, 1), b3 + hstep, voffB); PG8_STAGE(PG8_SA(1, 0), a3, voffA);
            PG8_WAIT_V(8); PG8_WAIT_L(0); PG8_BAR; PG8_MMA(1, 0, At, B0); PG8_MMA(1, 1, At, B1); PG8_BAR; PG8_SCHED;
            } else {
            PG8_LDB(B0, 0, 0); PG8_SCHED; PG8_LDA(At, 0, 0); PG8_STAGE(PG8_SA(1, 1), a1 + hstep, voffA);
            PG8_WAIT_L(8); PG8_BAR; PG8_WAIT_L(0); PG8_MMA(0, 0, At, B0); PG8_BAR; PG8_SCHED;
            PG8_LDB(B1, 0, 1); PG8_STAGE(PG8_SB(0, 0), b2, voffB);
            PG8_BAR; PG8_WAIT_L(0); PG8_MMA(0, 1, At, B1); PG8_BAR;
            PG8_LDA(At, 0, 1); PG8_STAGE(PG8_SA(0, 0), a2, voffA);
            PG8_BAR; PG8_WAIT_L(0); PG8_MMA(1, 0, At, B0); PG8_BAR; PG8_SCHED;
            PG8_STAGE(PG8_SB(0, 1), b2 + hstep, voffB);
            PG8_WAIT_V(6); PG8_BAR; PG8_MMA(1, 1, At, B1); PG8_BAR;
            PG8_LDB(B0, 1, 0); PG8_SCHED; PG8_LDA(At, 1, 0); PG8_STAGE(PG8_SA(0, 1), a2 + hstep, voffA);
            PG8_WAIT_L(8); PG8_BAR; PG8_WAIT_L(0); PG8_MMA(0, 0, At, B0); PG8_BAR; PG8_SCHED;
            PG8_LDB(B1, 1, 1); PG8_STAGE(PG8_SB(1, 0), b3, voffB);
            PG8_BAR; PG8_WAIT_L(0); PG8_MMA(0, 1, At, B1); PG8_BAR;
            PG8_LDA(At, 1, 1); PG8_STAGE(PG8_SA(1, 0), a3, voffA);
            PG8_BAR; PG8_WAIT_L(0); PG8_MMA(1, 0, At, B0); PG8_BAR; PG8_SCHED;
            PG8_STAGE(PG8_SB(1, 1), b3 + hstep, voffB);
            PG8_WAIT_V(6); PG8_BAR; PG8_MMA(1, 1, At, B1); PG8_BAR;
            }
        }
        if constexpr (ALIGN_EPI) { if (wr == 0) PG8_BAR; }
        if constexpr (F8) asm volatile("s_nop 15\n\ts_nop 15" ::: "memory");
        if constexpr (!Epi::AFTER_DRAIN) { E(acc, cur, wr, wc, fr, fq); S.done(cur); }
        if (!has_next) break;
#pragma unroll
        for (int a = 0; a < 2; ++a)
#pragma unroll
            for (int b = 0; b < 2; ++b)
#pragma unroll
                for (int m = 0; m < 4; ++m)
#pragma unroll
                    for (int n = 0; n < 2; ++n) { f32x4 z_ = (f32x4){0.f, 0.f, 0.f, 0.f}; asm volatile("" : "+v"(z_)); acc[a][b][m][n] = z_; }
        cur = nxt; cA = nA; cB = nB; ++ui;
        if constexpr (ALIGN_EPI) { if (wr == 1) PG8_BAR; }
    }
    PG8_WAIT_V(0);
    if constexpr (!ALIGN_EPI) { if (wr == 0) PG8_BAR; }
    PG8_BAR;
    if constexpr (Epi::AFTER_DRAIN) { E.fused(acc, cur, wr, wc, fr, fq, lds, wid, lane); S.done(cur); }
#undef PG8_SA
#undef PG8_SB
#undef PG8_STAGE
#undef PG8_LDA
#undef PG8_LDB
#undef PG8_MMA
#undef PG8_CAT
#undef PG8_RD16
#undef PG8_WAIT_V
#undef PG8_WAIT_L
#undef PG8_BAR
#undef PG8_SCHED
}
}

#ifndef PG8_SP2
#define PG8_SP2 false
#endif
#ifndef PG8_ALIGN
#define PG8_ALIGN true
#endif
#include <hip/hip_bf16.h>
#include <cmath>
namespace attn_body {
using bf16=__hip_bfloat16;
using bf16x8=__attribute__((ext_vector_type(8)))short;
using s16x4=__attribute__((ext_vector_type(4)))short;
using f32x16=__attribute__((ext_vector_type(16)))float;
using u32x4=__attribute__((ext_vector_type(4)))unsigned;
constexpr int BATCH=2,NHEAD=16,SEQ=8192,D=64;
constexpr int NW=8,QBLK=32,QB=QBLK*NW,KVBLK=64,NQB=SEQ/QB;
constexpr int ATTN_UNIT_ROWS=QB;
__device__ __forceinline__ int crow(int r,int hi){return (r&3)+8*(r>>2)+4*hi;}
#define SBAR() __builtin_amdgcn_sched_barrier(0)
typedef __attribute__((address_space(3))) const float* lds_fptr;
typedef float f32x4n __attribute__((ext_vector_type(4)));
constexpr float NA_NEG=-1000.f; constexpr int NA_TROW=132, NA_TCOPY=15*NA_TROW;
constexpr unsigned long long na_lanemask(int par,int P,int r){ unsigned long long m=0;
  for(int lane=0;lane<64;++lane){ const int r32=lane&31,hi=lane>>5,c=32*par+r32; int cs=c-8; cs=cs<0?0:(cs>48?48:cs); const int kc=(r&3)+8*(r>>2)+4*hi+32*P; if(kc-cs>=0&&kc-cs<16)m|=1ull<<lane; }
  return m; }
template<int PAR,int P,int R> struct NaM { static constexpr unsigned long long v=na_lanemask(PAR,P,R); };
template<int PAR,int P,int G> struct NaG { static constexpr bool any=(NaM<PAR,P,4*G>::v|NaM<PAR,P,4*G+1>::v|NaM<PAR,P,4*G+2>::v|NaM<PAR,P,4*G+3>::v)!=0ull; };
template<int PAR,int P,int R> __device__ __forceinline__ float na_el(float x,float b){
  constexpr unsigned long long m=NaM<PAR,P,R>::v;
  if constexpr(m==0ull){ return NA_NEG; }
  else{ float y=x+b; if constexpr(m!=~0ull){ asm("v_cndmask_b32 %0, %1, %0, %2":"+v"(y):"v"(NA_NEG),"s"(m)); } return y; }
}
template<int PAR,int P,int G> __device__ __forceinline__ void na_grp(f32x16&p,lds_fptr tr,float mh){
  if constexpr(NaG<PAR,P,G>::any){ const f32x4n b=*(const __attribute__((address_space(3))) f32x4n*)(tr+32*P+8*G)-mh;
    p[4*G]=na_el<PAR,P,4*G>(p[4*G],b[0]); p[4*G+1]=na_el<PAR,P,4*G+1>(p[4*G+1],b[1]); p[4*G+2]=na_el<PAR,P,4*G+2>(p[4*G+2],b[2]); p[4*G+3]=na_el<PAR,P,4*G+3>(p[4*G+3],b[3]); }
  else{ p[4*G]=NA_NEG;p[4*G+1]=NA_NEG;p[4*G+2]=NA_NEG;p[4*G+3]=NA_NEG; }
}
template<int PAR> __device__ __forceinline__ void namask(f32x16&p0,f32x16&p1,int t,int rowlo,int robase,lds_fptr tr0,float mh){
  if((unsigned)(t-rowlo)>=8u){
    #pragma unroll
    for(int r=0;r<16;++r){p0[r]=NA_NEG;p1[r]=NA_NEG;}
  }else{
    lds_fptr tr=tr0+(robase+t)*NA_TROW;
    na_grp<PAR,0,0>(p0,tr,mh);na_grp<PAR,0,1>(p0,tr,mh);na_grp<PAR,0,2>(p0,tr,mh);na_grp<PAR,0,3>(p0,tr,mh);
    na_grp<PAR,1,0>(p1,tr,mh);na_grp<PAR,1,1>(p1,tr,mh);na_grp<PAR,1,2>(p1,tr,mh);na_grp<PAR,1,3>(p1,tr,mh);
  }
}
constexpr int NSLOT=3, SLOTB=8192;
constexpr int LDS_K=0, LDS_V=NSLOT*SLOTB, LDS_WS=2*NSLOT*SLOTB, LDS_OST=LDS_WS+NW*64*4, LDS_BYTES=LDS_OST+NW*4096;
constexpr float C2=0.125f*1.4426950408889634f;
__device__ __forceinline__ void glds16(const void*gsrc,unsigned lds_dst){unsigned keep;
  asm volatile("s_mov_b32 %0, m0\n\ts_mov_b32 m0, %2\n\ts_nop 0\n\tglobal_load_lds_dwordx4 %1, off\n\ts_mov_b32 m0, %0":"=&s"(keep):"v"(gsrc),"s"(lds_dst):"memory");}
__device__ __forceinline__ float max3f(float a,float b,float c){float r;asm("v_max3_f32 %0, %1, %2, %3":"=v"(r):"v"(a),"v"(b),"v"(c));return r;}
__device__ __forceinline__ float max2f(float a,float b){float r;asm("v_max_f32_e32 %0, %1, %2":"=v"(r):"v"(a),"v"(b));return r;}
__device__ __forceinline__ float fadd_s(float a,float b){float r;asm("v_add_f32_e32 %0, %1, %2":"=v"(r):"v"(a),"v"(b));return r;}
__device__ __forceinline__ float fsub_s(float a,float b){float r;asm("v_sub_f32_e32 %0, %1, %2":"=v"(r):"v"(a),"v"(b));return r;}
typedef float f32x2_t __attribute__((ext_vector_type(2))); typedef __bf16 bf16x2_t __attribute__((ext_vector_type(2)));
__device__ __forceinline__ unsigned cvtpk_s(float lo,float hi){f32x2_t v={lo,hi};bf16x2_t b=__builtin_convertvector(v,bf16x2_t);return __builtin_bit_cast(unsigned,b);}
#define WAIT_BAR(N) asm volatile("s_waitcnt vmcnt(" #N ") lgkmcnt(0)\n\ts_barrier":::"memory")

__device__ __forceinline__ void qkt(f32x16&p0,f32x16&p1,const char*Kslot,const bf16x8*qr,const f32x16&negm,int r32,int hi){
  const char*kb=Kslot+hi*1024+r32*16;
  #pragma unroll
  for(int d0=0;d0<4;++d0){
    const bf16x8 b0=*reinterpret_cast<const bf16x8*>(kb+d0*2048);
    const bf16x8 b1=*reinterpret_cast<const bf16x8*>(kb+d0*2048+512);
    if(d0==0){p0=__builtin_amdgcn_mfma_f32_32x32x16_bf16(b0,qr[0],negm,0,0,0);p1=__builtin_amdgcn_mfma_f32_32x32x16_bf16(b1,qr[0],negm,0,0,0);}
    else{p0=__builtin_amdgcn_mfma_f32_32x32x16_bf16(b0,qr[d0],p0,0,0,0);p1=__builtin_amdgcn_mfma_f32_32x32x16_bf16(b1,qr[d0],p1,0,0,0);}}
}
typedef __attribute__((address_space(3))) const char* lds_cptr;
typedef short v4i16_t __attribute__((ext_vector_type(4)));
__device__ __forceinline__ void kload8(bf16x8*kf,lds_cptr kp){
  kf[0]=*(const __attribute__((address_space(3))) bf16x8*)(kp);      kf[1]=*(const __attribute__((address_space(3))) bf16x8*)(kp+512);
  kf[2]=*(const __attribute__((address_space(3))) bf16x8*)(kp+2048); kf[3]=*(const __attribute__((address_space(3))) bf16x8*)(kp+2560);
  kf[4]=*(const __attribute__((address_space(3))) bf16x8*)(kp+4096); kf[5]=*(const __attribute__((address_space(3))) bf16x8*)(kp+4608);
  kf[6]=*(const __attribute__((address_space(3))) bf16x8*)(kp+6144); kf[7]=*(const __attribute__((address_space(3))) bf16x8*)(kp+6656);
}
__device__ __forceinline__ void kload2(bf16x8*kf,lds_cptr kp,int j){ kf[2*j]=*(const __attribute__((address_space(3))) bf16x8*)(kp+j*2048); kf[2*j+1]=*(const __attribute__((address_space(3))) bf16x8*)(kp+j*2048+512); }
__device__ __forceinline__ s16x4 vtr(lds_cptr p){ return __builtin_bit_cast(s16x4,__builtin_amdgcn_ds_read_tr16_b64_v4i16((__attribute__((address_space(3))) v4i16_t*)p)); }
__device__ __forceinline__ float rowmax(const f32x16&p0,const f32x16&p1){
  float a=max3f(p0[0],p0[1],p1[0]),b=max3f(p0[2],p0[3],p1[1]);a=max3f(a,p1[2],p1[3]);
  #pragma unroll
  for(int r=4;r<16;r+=4){a=max3f(a,p0[r],p0[r+1]);b=max3f(b,p0[r+2],p0[r+3]);a=max3f(a,p1[r],p1[r+1]);b=max3f(b,p1[r+2],p1[r+3]);}
  const float m=max2f(a,b);
  auto rr=__builtin_amdgcn_permlane32_swap(__float_as_uint(m),__float_as_uint(m),false,false);
  return max2f(__uint_as_float(rr[0]),__uint_as_float(rr[1]));
}
__device__ __forceinline__ void pv(f32x16*o,int vb,bf16x8 pa0,bf16x8 pa1,bf16x8 pa2,bf16x8 pa3){
  #pragma unroll
  for(int d0=0;d0<2;++d0){s16x4 lo[4],hi[4];
    #pragma unroll
    for(int ks=0;ks<4;++ks){
      asm volatile("ds_read_b64_tr_b16 %0,%1 offset:%c2":"=&v"(lo[ks]):"v"(vb),"i"(d0*4096+ks*1024):"memory");
      asm volatile("ds_read_b64_tr_b16 %0,%1 offset:%c2":"=&v"(hi[ks]):"v"(vb),"i"(d0*4096+ks*1024+512):"memory");}
    asm volatile("s_waitcnt lgkmcnt(0)":::"memory");SBAR();
    #define PK(k) (bf16x8){lo[k][0],lo[k][1],lo[k][2],lo[k][3],hi[k][0],hi[k][1],hi[k][2],hi[k][3]}
    o[d0]=__builtin_amdgcn_mfma_f32_32x32x16_bf16(pa0,PK(0),o[d0],0,0,0);
    o[d0]=__builtin_amdgcn_mfma_f32_32x32x16_bf16(pa1,PK(1),o[d0],0,0,0);
    o[d0]=__builtin_amdgcn_mfma_f32_32x32x16_bf16(pa2,PK(2),o[d0],0,0,0);
    o[d0]=__builtin_amdgcn_mfma_f32_32x32x16_bf16(pa3,PK(3),o[d0],0,0,0);
    #undef PK
  }
}

struct SideJob { const float* mg; const float* mu; unsigned char* wt; int p0, cnt; unsigned lds; float scale; };
constexpr int SJ_K=1024, SJ_N=3584, SJ_NB=SJ_N/32, SJ_PK=8, SJ_MODE=0, SJ_KP=SJ_K/SJ_PK, SJ_SLOT=SJ_PK*32*4, SJ_STAGE=4*SJ_SLOT;
__device__ __forceinline__ void glds16s(const void*sbase,unsigned voff,unsigned lds_dst){unsigned keep;
  asm volatile("s_mov_b32 %0, m0\n\ts_mov_b32 m0, %3\n\ts_nop 3\n\tglobal_load_lds_dwordx4 %1, %2\n\ts_mov_b32 m0, %0":"=&s"(keep):"v"(voff),"s"(sbase),"s"(lds_dst):"memory");}
__device__ __forceinline__ void glds16u(const void*sbase,unsigned voff,unsigned lds_dst){unsigned keep;
  asm volatile("s_mov_b32 %0, m0\n\ts_mov_b32 m0, %3\n\ts_nop 0\n\tglobal_load_lds_dwordx4 %1, %2\n\ts_mov_b32 m0, %0":"=&s"(keep):"v"(voff),"s"(sbase),"s"(lds_dst):"memory");}
#ifndef ATTN_STORE16
#define ATTN_STORE16(p,v) (*(u32x4*)(p)=(v))
#endif
template<int MODE,int PQ,int PK,int THRL,bool NOMAX,bool ODD=false,bool SIDE=false> __device__ __forceinline__ void attn_unit(int b,int hq,int hk,int q0,int k0,int NT,const bf16*Q,const bf16*__restrict__ K,const bf16*__restrict__ V,bf16*O,char*shm,int na_r0,int na_first,lds_fptr na_tab,const SideJob sj=SideJob{}){
  int tid_=threadIdx.x; asm volatile("":"+v"(tid_)); const int tid=tid_,lane=tid&63,r32=lane&31,hi=lane>>5; const int wid=__builtin_amdgcn_readfirstlane(tid>>6);
  const long rowbase=(long)b*SEQ;
  const bf16*Qw=Q+(rowbase+q0+wid*QBLK)*PQ+hq*D;
  const bf16*Kh=K+(rowbase+k0)*PK+hk*D,*Vh=V+(rowbase+k0)*PK+hk*D;
  const unsigned lds0=(unsigned)(uintptr_t)shm;
  float*wsf=(float*)(shm+LDS_WS)+wid*64;
  const unsigned kvo=(unsigned)((lane*PK+wid*8)*2);
  const unsigned vvo=(unsigned)(((16*(wid&3)+(lane>>2))*PK+(wid>>2)*32+(lane&3)*8)*2);
  const unsigned kdst=lds0+LDS_K+wid*1024, vdst=lds0+LDS_V+wid*1024;
  #define DMA_K(t,slot) glds16u(Kh+(long)(t)*KVBLK*PK,kvo,(unsigned)__builtin_amdgcn_readfirstlane(kdst+(slot)))
  #define DMA_V(t,slot) glds16u(Vh+(long)(t)*KVBLK*PK,vvo,(unsigned)__builtin_amdgcn_readfirstlane(vdst+(slot)))
  const int vb0=(int)(lds0+LDS_V)+((lane>>4)&1)*32+(lane&3)*8+(4*hi+((lane&15)>>2))*64;
  const char*Kbase=shm+LDS_K; bf16x8 kf[8];
  const lds_cptr shm3=(lds_cptr)shm; const lds_cptr kp0=shm3+LDS_K+hi*1024+r32*16; const lds_cptr vp0=shm3+LDS_V+((lane>>4)&1)*32+(lane&3)*8+(4*hi+((lane&15)>>2))*64;
  DMA_K(0,0);DMA_V(0,0);DMA_K(1,SLOTB);
  bf16x8 qr[4];
  #pragma unroll
  for(int d0=0;d0<4;++d0)qr[d0]=*reinterpret_cast<const bf16x8*>(&Qw[(long)r32*PQ+d0*16+hi*8]);
  float mhat=0.f,l_reg=0.f;f32x16 o[2];o[0]=f32x16{};o[1]=f32x16{};f32x16 negm=f32x16{}; if constexpr(!NOMAX&&MODE!=1) asm volatile("":"+v"(negm));
  int na_rowlo=0,na_robase=0; lds_fptr na_tr0=na_tab;
  if constexpr(MODE==1){ const int r_=na_r0+(wid>>1), c_=32*(wid&1)+r32; int rs_=r_-4; rs_=rs_<0?0:(rs_>SEQ/64-8?SEQ/64-8:rs_);
    na_rowlo=__builtin_amdgcn_readfirstlane(rs_-na_first); na_robase=__builtin_amdgcn_readfirstlane(na_first-r_+7); na_tr0=na_tab+(c_&3)*NA_TCOPY+(64-(c_-(c_&3))+4*hi); }
  #define CMASK(P0,P1,t) do{ if constexpr(MODE==1){ if(wid&1) namask<1>(P0,P1,(t),na_rowlo,na_robase,na_tr0,mhat); else namask<0>(P0,P1,(t),na_rowlo,na_robase,na_tr0,mhat); } }while(0)
  bool resc=false;
  #define START(P0,P1) do{ if constexpr(!NOMAX){ const float rm=rowmax(P0,P1); resc=false; \
    { const float dl=rm; mhat=fadd_s(mhat,dl); \
      _Pragma("unroll") for(int r=0;r<16;++r){P0[r]=fsub_s(P0[r],dl);P1[r]=fsub_s(P1[r],dl);} \
      if constexpr(MODE!=1){ _Pragma("unroll") for(int r=0;r<16;++r)negm[r]=-mhat; asm volatile("":"+v"(negm)); } } } \
    _Pragma("unroll") for(int r=0;r<16;++r)P0[r]=__builtin_amdgcn_exp2f(P0[r]); }while(0)
  #define RESC() do{ if constexpr(!NOMAX) if(resc){ asm volatile("s_waitcnt lgkmcnt(0)":::"memory"); \
      _Pragma("unroll") for(int d_=0;d_<2;++d_) _Pragma("unroll") for(int r=0;r<16;++r)o[d_][r]*=wsf[crow(r,hi)]; } }while(0)
  f32x16 pA0,pA1,pB0,pB1;
  typedef short sj_v2s __attribute__((ext_vector_type(2))); const float sj_iscale=1.0f/sj.scale;
  int sj_c=0; float sa0=0.f,sa1=0.f,sa2=0.f,sa3=0.f;
  const int sj_p0=sj.p0+wid*sj.cnt; const unsigned sj_lds=(unsigned)__builtin_amdgcn_readfirstlane((int)(sj.lds+wid*SJ_STAGE));
  const unsigned sj_vld=(unsigned)(((lane>>3)*SJ_N+4*(lane&7))*4), sj_vst=(unsigned)((lane>>3)*SJ_K+16*(lane&7));
  const unsigned sj_bw=(unsigned)(lds0+LDS_OST+wid*4096+(lane&31)*128+4*(lane>>5)), sj_bx=(unsigned)((lane&7)<<4);
  const unsigned sj_br=(unsigned)(lds0+LDS_OST+wid*4096+(lane>>3)*128+(((lane&7)^((lane>>3)&7))<<4));
  const __attribute__((address_space(3))) float*sj_rd=(const __attribute__((address_space(3))) float*)(uintptr_t)(sj.lds+wid*SJ_STAGE+(lane>>5)*512+(lane&31)*4);
  #define SIDE_RD() do{ const __attribute__((address_space(3))) float*rp_=sj_rd+(((sj_c+1)&3)<<8); sa0=rp_[0];sa1=rp_[32];sa2=rp_[64];sa3=rp_[96]; }while(0)
  #define SIDE_ST(c_) (SJ_MODE==0&&(c_)>=18&&(c_)-3<sj.cnt&&(((c_)-3)&15)==15)
  const float*sj_srcA=sj.mg,*sj_srcB=sj.mg; unsigned char*sj_dstA=sj.wt,*sj_dstB=sj.wt; int sj_w=0;
  if constexpr(SIDE){
    #define SJ_DEC(p_,SRC,DST) do{ const int kp_=(p_)%SJ_KP, q_=(p_)/SJ_KP, eu_=q_/SJ_NB, nb_=q_-eu_*SJ_NB, e_=eu_>>1, up_=eu_&1; \
      SRC=(up_?sj.mu:sj.mg)+((size_t)(e_*SJ_K+SJ_PK*kp_)*SJ_N+32*nb_); DST=sj.wt+(size_t)e_*(2*SJ_N*SJ_K)+(size_t)(256*(nb_>>2)+32*(nb_&3)+128*up_)*SJ_K+SJ_PK*kp_; }while(0)
    sj_w=SJ_KP-(sj_p0%SJ_KP); SJ_DEC(sj_p0,sj_srcA,sj_dstA); SJ_DEC(sj_p0+sj_w,sj_srcB,sj_dstB);
    #undef SJ_DEC
  }
  #define SIDE_LD() do{ const int cm_=sj.cnt-1; const int il_=sj_c>cm_?cm_:sj_c; const float*sp_=il_<sj_w?sj_srcA+(size_t)il_*(SJ_PK*SJ_N):sj_srcB+(size_t)(il_-sj_w)*(SJ_PK*SJ_N); glds16s(sp_,sj_vld,sj_lds+((sj_c&3)<<10)); }while(0)
  #define SIDE_CV() do{ \
    { sj_v2s lo_={0,0}; lo_=__builtin_amdgcn_cvt_scalef32_pk_fp8_f32(lo_,sa0,sa1,sj_iscale,false); lo_=__builtin_amdgcn_cvt_scalef32_pk_fp8_f32(lo_,sa2,sa3,sj_iscale,true);     \
      const int q_=sj_c-3; if(q_>=0&&q_<sj.cnt){ const unsigned qq_=(unsigned)q_&15u;       \
        *(__attribute__((address_space(3))) unsigned*)(uintptr_t)(sj_bw+((((qq_>>1)<<4))^sj_bx)+((qq_&1u)<<3))=__builtin_bit_cast(unsigned,lo_); } } \
    if(SIDE_ST(sj_c)){ const int ib_=sj_c-18; unsigned char*dp_=(ib_<sj_w?sj_dstA+SJ_PK*ib_:sj_dstB+SJ_PK*(ib_-sj_w))+sj_vst;     \
      _Pragma("unroll") for(int j_=0;j_<4;++j_){ const u32x4 w_=*(const __attribute__((address_space(3))) u32x4*)(uintptr_t)(sj_br+j_*1024); *(u32x4*)(dp_+(size_t)j_*8*SJ_K)=w_; SBAR(); } } \
    ++sj_c; SBAR(); }while(0)
  #define SIDE_WAIT() do{ if(SIDE_ST(sj_c-1)||SIDE_ST(sj_c-2)){WAIT_BAR(8);}else{WAIT_BAR(4);} }while(0)
  int sl_prev=0,sl_cur=0,sl_next=SLOTB;
  #define ROT() do{sl_prev=sl_cur;sl_cur=sl_next;sl_next=(sl_next==(NSLOT-1)*SLOTB)?0:sl_next+SLOTB;}while(0)
  DMA_K(2,2*SLOTB);
  WAIT_BAR(3);
  qkt(pA0,pA1,Kbase,qr,negm,r32,hi);asm volatile("s_nop 15\n\ts_nop 7":"+v"(pA0),"+v"(pA1));CMASK(pA0,pA1,0);
  START(pA0,pA1);
  _Pragma("unroll") for(int r=0;r<16;++r)pA1[r]=__builtin_amdgcn_exp2f(pA1[r]);
  WAIT_BAR(0);
  DMA_K(3,0);DMA_V(1,SLOTB);
  if constexpr(SIDE){ SIDE_LD(); SIDE_CV(); }
  ROT();
  kload8(kf,kp0+sl_cur);
  if constexpr(SIDE){WAIT_BAR(3);}else{WAIT_BAR(2);}
  s16x4 vlo[8],vhi[8]; u32x4 pw0,pw1,pw2,pw3;
  #define PKW(P,B) cvtpk_s(P[B],P[B+1])
  #define PAF(k) __builtin_bit_cast(bf16x8,pw##k)
  #define VFR(i) (bf16x8){vlo[i][0],vlo[i][1],vlo[i][2],vlo[i][3],vhi[i][0],vhi[i][1],vhi[i][2],vhi[i][3]}
  #define PIN(x) asm volatile("":"+v"(x))
  #define MX3(a,b,c) __builtin_fmaxf(__builtin_fmaxf((a),(b)),(c))
  #define GAPA(MF,A0,A1,A2,A3,W0,W1,PW) do{ MF; sacc+=A0; sacc+=A1; sacc+=A2; sacc+=A3; PIN(sacc); W0; W1; PIN(PW); SBAR(); }while(0)
  #define EX(v) __builtin_amdgcn_exp2f(v)
  #define GAPB(MF,X,B) do{ MF; X[B]=EX(X[B]); X[B+1]=EX(X[B+1]); X[B+2]=EX(X[B+2]); X[B+3]=EX(X[B+3]); PIN(X); SBAR(); }while(0)
  #define VRD(i) do{ vlo[i]=vtr(vp_+(((i)>>2)*4096+((i)&3)*1024)); vhi[i]=vtr(vp_+(((i)>>2)*4096+((i)&3)*1024+512)); }while(0)
  #define KRD(G,j) do{ if(G){ kload2(kf,kp0+sl_next,j); SBAR(); } }while(0)
  #define STEP(C0,C1,P0,P1,t,GK,GV,GL,SD) do{ SBAR(); if constexpr(SD){ SIDE_RD(); if(GK){DMA_K((t)+3,sl_cur);} if(GV){DMA_V((t)+1,sl_next);} SIDE_LD(); SBAR(); } \
    const lds_cptr vp_=vp0+sl_prev; \
    VRD(0); SBAR(); float sacc=(P0[0]+P0[1]); \
    GAPA(C0=__builtin_amdgcn_mfma_f32_32x32x16_bf16(kf[0],qr[0],negm,0,0,0), P0[2],P0[3],P0[4],P0[5],     pw0[0]=PKW(P0,0), pw0[1]=PKW(P0,2), pw0); \
    VRD(4); SBAR(); GAPA(C1=__builtin_amdgcn_mfma_f32_32x32x16_bf16(kf[1],qr[0],negm,0,0,0), P0[6],P0[7],P0[8],P0[9],     pw0[2]=PKW(P0,4), pw0[3]=PKW(P0,6), pw0); \
    VRD(1); SBAR(); GAPA(C0=__builtin_amdgcn_mfma_f32_32x32x16_bf16(kf[2],qr[1],C0,0,0,0),   P0[10],P0[11],P0[12],P0[13], pw1[0]=PKW(P0,8), pw1[1]=PKW(P0,10), pw1); \
    VRD(5); SBAR(); GAPA(C1=__builtin_amdgcn_mfma_f32_32x32x16_bf16(kf[3],qr[1],C1,0,0,0),   P0[14],P0[15],P1[0],P1[1],   pw1[2]=PKW(P0,12),pw1[3]=PKW(P0,14), pw1); \
    VRD(2); SBAR(); GAPA(C0=__builtin_amdgcn_mfma_f32_32x32x16_bf16(kf[4],qr[2],C0,0,0,0),   P1[2],P1[3],P1[4],P1[5],     pw2[0]=PKW(P1,0), pw2[1]=PKW(P1,2), pw2); \
    VRD(6); SBAR(); GAPA(C1=__builtin_amdgcn_mfma_f32_32x32x16_bf16(kf[5],qr[2],C1,0,0,0),   P1[6],P1[7],P1[8],P1[9],     pw2[2]=PKW(P1,4), pw2[3]=PKW(P1,6), pw2); \
    VRD(3); SBAR(); GAPA(C0=__builtin_amdgcn_mfma_f32_32x32x16_bf16(kf[6],qr[3],C0,0,0,0),   P1[10],P1[11],P1[12],P1[13], pw3[0]=PKW(P1,8), pw3[1]=PKW(P1,10), pw3); \
    VRD(7); SBAR(); GAPA(C1=__builtin_amdgcn_mfma_f32_32x32x16_bf16(kf[7],qr[3],C1,0,0,0),   P1[14],P1[15],0.f,0.f,       pw3[2]=PKW(P1,12),pw3[3]=PKW(P1,14), pw3); \
    l_reg+=sacc; \
    if constexpr(SD){ SIDE_CV(); }else{ if(GK){DMA_K((t)+3,sl_cur);} if(GV){DMA_V((t)+1,sl_next);} } \
    CMASK(C0,C1,t); \
    if constexpr(!NOMAX){ float a=MX3(C0[0],C0[1],C1[0]),b=MX3(C0[2],C0[3],C1[1]); a=MX3(a,C1[2],C1[3]); \
      _Pragma("unroll") for(int r=4;r<16;r+=4){a=MX3(a,C0[r],C0[r+1]);b=MX3(b,C0[r+2],C0[r+3]);a=MX3(a,C1[r],C1[r+1]);b=MX3(b,C1[r+2],C1[r+3]);} \
      float rm=__builtin_fmaxf(a,b); { auto rr=__builtin_amdgcn_permlane32_swap(__float_as_uint(rm),__float_as_uint(rm),false,false); rm=__builtin_fmaxf(__uint_as_float(rr[0]),__uint_as_float(rr[1])); } \
      resc=false; \
      if(__builtin_expect(__any(rm>(float)THRL),0)){ const float dl=__builtin_fmaxf(rm,0.f); mhat+=dl; \
        _Pragma("unroll") for(int r=0;r<16;++r){C0[r]-=dl;C1[r]-=dl;} \
        if constexpr(MODE!=1){ _Pragma("unroll") for(int r=0;r<16;++r)negm[r]=-mhat; asm volatile("":"+v"(negm)); } \
        const float f=__builtin_amdgcn_exp2f(-dl); l_reg*=f; if(hi==0)wsf[r32]=f; resc=true; } } \
    SBAR(); \
    GAPB(o[0]=__builtin_amdgcn_mfma_f32_32x32x16_bf16(PAF(0),VFR(0),o[0],0,0,0), C0,0); \
    GAPB(o[1]=__builtin_amdgcn_mfma_f32_32x32x16_bf16(PAF(0),VFR(4),o[1],0,0,0), C0,4); \
    KRD(GL,0); GAPB(o[0]=__builtin_amdgcn_mfma_f32_32x32x16_bf16(PAF(1),VFR(1),o[0],0,0,0), C0,8); \
    KRD(GL,1); GAPB(o[1]=__builtin_amdgcn_mfma_f32_32x32x16_bf16(PAF(1),VFR(5),o[1],0,0,0), C0,12); \
    KRD(GL,2); GAPB(o[0]=__builtin_amdgcn_mfma_f32_32x32x16_bf16(PAF(2),VFR(2),o[0],0,0,0), C1,0); \
    KRD(GL,3); GAPB(o[1]=__builtin_amdgcn_mfma_f32_32x32x16_bf16(PAF(2),VFR(6),o[1],0,0,0), C1,4); \
    GAPB(o[0]=__builtin_amdgcn_mfma_f32_32x32x16_bf16(PAF(3),VFR(3),o[0],0,0,0), C1,8); \
    GAPB(o[1]=__builtin_amdgcn_mfma_f32_32x32x16_bf16(PAF(3),VFR(7),o[1],0,0,0), C1,12); \
    }while(0)
  int t=1;
  asm volatile(".p2align 6");
  for(;t+5<NT;t+=2){
    STEP(pB0,pB1,pA0,pA1,t,true,true,true,SIDE);     if constexpr(SIDE){SIDE_WAIT();}else{WAIT_BAR(2);} RESC(); ROT();
    STEP(pA0,pA1,pB0,pB1,t+1,true,true,true,SIDE);   if constexpr(SIDE){SIDE_WAIT();}else{WAIT_BAR(2);} RESC(); ROT();
  }
  #define ENDW(tt) do{ if((tt)+3<NT){WAIT_BAR(2);} else if((tt)+2<NT){WAIT_BAR(1);} else {WAIT_BAR(0);} }while(0)
  for(;t+1<NT;t+=2){
    STEP(pB0,pB1,pA0,pA1,t,(t+3<NT),(t+1<NT),(t+1<NT),false);       ENDW(t);   RESC(); ROT();
    STEP(pA0,pA1,pB0,pB1,t+1,(t+4<NT),(t+2<NT),(t+2<NT),false);     ENDW(t+1); RESC(); ROT();
  }
  #define DRAIN(D0,D1,VSL) do{ float sacc=D0[0]+D0[1]; _Pragma("unroll") for(int r=2;r<16;++r)sacc+=D0[r]; _Pragma("unroll") for(int r=0;r<16;++r)sacc+=D1[r]; l_reg+=sacc; \
    pw0=(u32x4){PKW(D0,0),PKW(D0,2),PKW(D0,4),PKW(D0,6)};pw1=(u32x4){PKW(D0,8),PKW(D0,10),PKW(D0,12),PKW(D0,14)};pw2=(u32x4){PKW(D1,0),PKW(D1,2),PKW(D1,4),PKW(D1,6)};pw3=(u32x4){PKW(D1,8),PKW(D1,10),PKW(D1,12),PKW(D1,14)}; \
    SBAR(); pv(o,vb0+(VSL),PAF(0),PAF(1),PAF(2),PAF(3)); }while(0)
  if constexpr(ODD){ DRAIN(pA0,pA1,sl_prev); }
  else{ STEP(pB0,pB1,pA0,pA1,NT-1,false,false,false,false); RESC(); DRAIN(pB0,pB1,sl_cur); }
  #undef DRAIN
  #undef PKW
  #undef PAF
  #undef VFR
  #undef PIN
  #undef MX3
  #undef GAPA
  #undef GAPB
  #undef EX
  #undef VRD
  #undef KRD
  #undef STEP
  #undef SIDE_RD
  #undef SIDE_LD
  #undef SIDE_CV
  #undef SIDE_ST
  #undef SIDE_WAIT
  #undef ENDW
  {auto rr=__builtin_amdgcn_permlane32_swap(__float_as_uint(l_reg),__float_as_uint(l_reg),false,false);l_reg=__uint_as_float(rr[0])+__uint_as_float(rr[1]);}
  if(hi==0)wsf[32+r32]=l_reg;asm volatile("s_waitcnt lgkmcnt(0)":::"memory");
  float rli[16];
  #pragma unroll
  for(int r=0;r<16;++r)rli[r]=__builtin_amdgcn_rcpf(wsf[32+crow(r,hi)]);
  bf16*Ow=O+(rowbase+q0+wid*QBLK)*PQ+hq*D;
  { bf16*stg=(bf16*)(shm+LDS_OST)+wid*2048;
    #pragma unroll
    for(int r=0;r<16;++r){const int orow=crow(r,hi);
      #pragma unroll
      for(int d0=0;d0<2;++d0)stg[orow*64+d0*32+r32]=__float2bfloat16(o[d0][r]*rli[r]);}
    asm volatile("s_waitcnt lgkmcnt(0)":::"memory");
    #pragma unroll
    for(int i=0;i<4;++i){const int row=i*8+(lane>>3),ch=lane&7; const u32x4 v=*(const u32x4*)(stg+row*64+ch*8); ATTN_STORE16(Ow+(long)row*PQ+ch*8,v);} }
  asm volatile("s_waitcnt lgkmcnt(0)\n\ts_barrier":::"memory");
  #undef DMA_K
  #undef DMA_V
  #undef CMASK
  #undef START
  #undef RESC
  #undef ROT
}
constexpr int ATTN_LDS_BYTES=LDS_BYTES;
#undef SBAR
#undef WAIT_BAR
}

constexpr int NWAVES = 8;
constexpr int BATCH = 2, SEQ = 8192, D = 1024, M = BATCH * SEQ, FF = 3584, NE = 8;
constexpr int NQKV0 = 3 * D, NQKV1 = D + 2 * 256, NKV = 256, HD = 64;
constexpr float EPS = 1e-6f;
constexpr float LOG2E = 1.4426950408889634f;
constexpr int NCHUNK = M / 64;
constexpr int MOE_MAXT = 135;
constexpr float Y8_SCALE = 16.f;
constexpr float WGU_SCALE = 64.f, WD_SCALE = 128.f;

constexpr size_t MiB = 1u << 20;
constexpr size_t WS_CTL = 0, CTL_ZERO_BYTES = 64 * 1024;
constexpr size_t WS_ROPE = 1 * MiB;
constexpr size_t WS_TOKE = 1 * MiB + 256 * 1024;
constexpr size_t WS_TOKG = 1 * MiB + 512 * 1024;
constexpr size_t WS_SLOT = 1 * MiB + 768 * 1024;
constexpr size_t WS_CCNT = 2 * MiB;
constexpr size_t WS_RS = 2 * MiB + 64 * 1024;
constexpr size_t WS_WGUM = 4 * MiB;
constexpr size_t WS_WDM = 60 * MiB;
constexpr size_t WS_WQKV0 = 88 * MiB, WS_WO0 = 94 * MiB, WS_WQKV1 = 96 * MiB, WS_WO1 = 99 * MiB, WS_WGU0 = 101 * MiB, WS_WD0 = 115 * MiB;
constexpr size_t WS_XN = 122 * MiB, WS_Q = 154 * MiB, WS_K = 186 * MiB, WS_V = 218 * MiB, WS_PO = 250 * MiB, WS_ACT = 282 * MiB;
constexpr size_t WS_XN8 = 394 * MiB;
constexpr size_t WS_APERM = 410 * MiB;
constexpr size_t WS_MACT = 122 * MiB;
constexpr size_t WS_Y = 282 * MiB;
constexpr size_t WS_YP = 350 * MiB;
constexpr int P16_KS = 7;
constexpr size_t WS_END = 444 * MiB;
static_assert(WS_WGUM + (size_t)NE * 2 * FF * D <= WS_WDM && WS_WDM + (size_t)NE * D * FF <= WS_WQKV0 && WS_WD0 + (size_t)D * FF * 2 <= WS_XN, "weight map");
static_assert(WS_ACT + (size_t)M * FF * 2 <= WS_XN8 && WS_XN8 + (size_t)M * D <= WS_APERM && WS_APERM + (size_t)MOE_MAXT * 256 * D <= WS_END, "activation map");
static_assert(WS_MACT + (size_t)MOE_MAXT * 256 * FF <= WS_PO && WS_Y + (size_t)MOE_MAXT * 256 * D * 2 <= WS_YP && WS_YP + (size_t)256 * 256 * 256 * 2 <= WS_XN8 && (FF / 128) % P16_KS == 0 && (FF / 128 / P16_KS) % 2 == 0, "MoE overlays");
constexpr int CW_TMO = 0;
constexpr int CW_BAR = 1024;

constexpr int RING_OFF = 0, RING_BYTES = 131072;
constexpr int SCR_WAVE = 64 * 65 * 4;
constexpr int NA_TAB_OFF = 90112;
constexpr int LDSCTL_OFF = 135168, MISC_WORDS = 256;
constexpr int LDS_BYTES = 147456;
static_assert(8 * SCR_WAVE <= LDSCTL_OFF && LDSCTL_OFF + MISC_WORDS * 4 <= LDS_BYTES && NA_TAB_OFF + 4 * 15 * 132 * 4 + 15 * 31 * 4 <= RING_BYTES && (D * 8) % (NWAVES * 64) == 0 && ((M / 64) * 8) % (NWAVES * 64) == 0, "LDS map");
constexpr int MW_BAR = 8;
constexpr int MW_TS = 16;
constexpr int MW_CNT = 32;
constexpr int MW_LT = 48;
#define GAS __attribute__((address_space(1)))
#define LAS __attribute__((address_space(3)))
typedef unsigned short bf16;
typedef unsigned v4u __attribute__((ext_vector_type(4)));
typedef float f32x4 __attribute__((ext_vector_type(4)));
typedef short bf16x8 __attribute__((ext_vector_type(8)));
typedef GAS unsigned gu32;
typedef GAS unsigned long long gu64;
#define RLX_AGENT __ATOMIC_RELAXED, __HIP_MEMORY_SCOPE_AGENT
#define LDS_WAIT() asm volatile("s_waitcnt lgkmcnt(0)" ::: "memory")
#define VM_WAIT() asm volatile("s_waitcnt vmcnt(0)" ::: "memory")
__device__ __forceinline__ unsigned long long rt() { return __builtin_amdgcn_s_memrealtime(); }
__device__ __forceinline__ unsigned f2bf(float f) { unsigned u = __builtin_bit_cast(unsigned, f); return (u + 0x7fffu + ((u >> 16) & 1u)) >> 16; }
__device__ __forceinline__ unsigned pk2(float lo, float hi) { return f2bf(lo) | (f2bf(hi) << 16); }

#define XB_TMO      128
#define XB_XCNT(j)  (256  + 64 * (j))
#define XB_XSUB(j)  (1280 + 64 * (j))
#define XB_XGEN(j)  (2304 + 64 * (j))
#define XB_TOP      3328
#define XB_TOPGEN   3392
#define XCD_BAR_WORDS 3456
#define XB_SPIN_CAP (1u << 18)

__device__ __forceinline__ unsigned xb_ld(unsigned* p)              { return __hip_atomic_load(p, __ATOMIC_RELAXED, __HIP_MEMORY_SCOPE_AGENT); }
__device__ __forceinline__ unsigned xb_add(unsigned* p, unsigned v) { return __hip_atomic_fetch_add(p, v, __ATOMIC_RELAXED, __HIP_MEMORY_SCOPE_AGENT); }
__device__ __forceinline__ unsigned xb_xcc_id() { return (unsigned)__builtin_amdgcn_s_getreg((3 << 11) | 20) & 0xFu; }
#define XB_SPIN(cond, bar) do { unsigned _sp = 0; while (cond) { __builtin_amdgcn_s_sleep(1); \
    if ((++_sp & 255u) == 0u) { if (xb_ld(&(bar)[XB_TMO])) break; if (_sp > XB_SPIN_CAP) { atomicAdd(&(bar)[XB_TMO], 1u); break; } } } } while (0)

struct XcdBarrier {
    unsigned* bar; unsigned x;
    volatile LAS unsigned* st;
};

__device__ __forceinline__ XcdBarrier xcd_barrier_post(unsigned* bar, volatile LAS unsigned* st) {
    XcdBarrier b; b.bar = bar; b.x = xb_xcc_id(); b.st = st;
    if (threadIdx.x == 0) (void)xb_add(&bar[XB_XCNT(b.x)], 1u);
    return b;
}
__device__ __forceinline__ void xcd_barrier_complete(unsigned* bar, unsigned x, unsigned& nloc, unsigned& nx) {
    const unsigned G = gridDim.x * gridDim.y * gridDim.z;
    unsigned sum, cnt, mine, sp = 0u;
    for (;;) {
        sum = 0u; cnt = 0u; mine = 0u;
#pragma unroll
        for (unsigned j = 0; j < 16; ++j) { const unsigned c = xb_ld(&bar[XB_XCNT(j)]); sum += c; cnt += (c > 0u) ? 1u : 0u; mine = (j == x) ? c : mine; }
        if (sum == G) break;
        __builtin_amdgcn_s_sleep(1);
        if ((++sp & 255u) == 0u) { if (xb_ld(&bar[XB_TMO])) break; if (sp > XB_SPIN_CAP) { atomicAdd(&bar[XB_TMO], 1u); break; } }
    }
    nloc = mine > 0u ? mine : 1u; nx = cnt > 0u ? cnt : 1u;
}

__device__ __forceinline__ void xcd_barrier(const XcdBarrier& b) {
    asm volatile("s_waitcnt vmcnt(0)" ::: "memory");
    __syncthreads();
    if (threadIdx.x == 0) {
        unsigned* bar = b.bar;
        __builtin_amdgcn_s_waitcnt(0);
        unsigned nloc = b.st[0], nx = b.st[1];
        if (nloc == 0u) { xcd_barrier_complete(bar, b.x, nloc, nx); b.st[0] = nloc; b.st[1] = nx; }
        const unsigned old = xb_add(&bar[XB_XSUB(b.x)], 1u);
        const unsigned gen = old / nloc;
        if (old + 1u == (gen + 1u) * nloc) {
            __builtin_amdgcn_fence(__ATOMIC_RELEASE, "agent");
            asm volatile("s_waitcnt vmcnt(0)" ::: "memory");
            const unsigned og = xb_add(&bar[XB_TOP], 1u);
            const unsigned tg = og / nx;
            if (og + 1u == (tg + 1u) * nx) xb_add(&bar[XB_TOPGEN], 1u);
            else XB_SPIN(xb_ld(&bar[XB_TOPGEN]) == tg, bar);
            __builtin_amdgcn_fence(__ATOMIC_ACQUIRE, "agent");
            xb_add(&bar[XB_XGEN(b.x)], 1u);
            asm volatile("s_waitcnt vmcnt(0)" ::: "memory");
        } else {
            XB_SPIN(xb_ld(&bar[XB_XGEN(b.x)]) == gen, bar);
            __builtin_amdgcn_fence(__ATOMIC_ACQUIRE, "agent");
            asm volatile("s_waitcnt vmcnt(0)" ::: "memory");
        }
    }
    __syncthreads();
}

typedef unsigned u32x2 __attribute__((ext_vector_type(2)));
struct Frame {
    LAS unsigned char* lds;
    volatile LAS unsigned* MISC;
    gu32* ctl;
    int tid, lane, wave;
    int vcu, G;
    unsigned char* ws;
};
__device__ __forceinline__ float wave_sum(float v) {
#pragma unroll
    for (int o = 1; o < 64; o <<= 1) v += __shfl_xor(v, o);
    return v;
}
__device__ __forceinline__ f32x4 ld_bf16x4(const bf16* p) { const u32x2 w = *(const GAS u32x2*)p;
    return (f32x4){__uint_as_float(w.x << 16), __uint_as_float(w.x & 0xffff0000u), __uint_as_float(w.y << 16), __uint_as_float(w.y & 0xffff0000u)}; }
__device__ __forceinline__ f32x4 ld_fp8x4(const unsigned char* p) { const int w = *(const GAS int*)p;
    return (f32x4){__builtin_amdgcn_cvt_f32_fp8(w, 0), __builtin_amdgcn_cvt_f32_fp8(w, 1), __builtin_amdgcn_cvt_f32_fp8(w, 2), __builtin_amdgcn_cvt_f32_fp8(w, 3)}; }
__device__ __forceinline__ void st_bf16x4(bf16* p, f32x4 v) { u32x2 w; w.x = pg8::cvt_pk_bf16(v.x, v.y); w.y = pg8::cvt_pk_bf16(v.z, v.w); *(GAS u32x2*)p = w; }
__device__ __forceinline__ float ssq4(const f32x4 (&v)[4]) { float s = 0.f;
#pragma unroll
    for (int j = 0; j < 4; ++j) s += (v[j].x * v[j].x + v[j].y * v[j].y) + (v[j].z * v[j].z + v[j].w * v[j].w);
    return wave_sum(s); }
__device__ __forceinline__ float rms_scale(float ss, int n) { return 1.0f / sqrtf(ss * (1.0f / (float)n) + EPS); }

struct TrDesc { const float* src; unsigned char* dst; int N, K, drow0, k0, n0, f8, perm; float scale; };
template <bool F8> __device__ __forceinline__ void tr_load(const TrDesc& d, f32x4 (&v)[16], int lane) {
    const int lr = lane >> 4, lc = (lane & 15) * 4;
    const float* p = d.src + (size_t)d.k0 * d.N + d.n0 + lc;
    if constexpr (F8) {
#pragma unroll
        for (int i = 0; i < 16; ++i) v[i] = *(const GAS f32x4*)(p + (size_t)(16 * (i >> 2) + 4 * lr + (i & 3)) * d.N);
    } else {
#pragma unroll
        for (int i = 0; i < 16; ++i) v[i] = *(const GAS f32x4*)(p + (size_t)(8 * (i >> 1) + 2 * lr + (i & 1)) * d.N);
    }
}
template <bool F8> __device__ __forceinline__ void tr_store(const TrDesc& d, const f32x4 (&v)[16], LAS unsigned* scr, int lane) {
    const int lr = lane >> 4, lc = (lane & 15) * 4;
    if constexpr (F8) {
        const float s = d.scale;
#pragma unroll
        for (int i = 0; i < 4; ++i) { LAS unsigned* q = scr + (4 * i + lr) * 65 + lc;
#pragma unroll
            for (int c = 0; c < 4; ++c) q[c] = pg8::cvt4_fp8(v[4 * i][c] * s, v[4 * i + 1][c] * s, v[4 * i + 2][c] * s, v[4 * i + 3][c] * s); }
        LDS_WAIT(); asm volatile("" ::: "memory");
        const int c4 = lane & 3, nn = lane >> 2;
#pragma unroll
        for (int j = 0; j < 4; ++j) { const int n = nn + 16 * j; const LAS unsigned* q = scr + (4 * c4) * 65 + n;
            v4u o; o.x = q[0]; o.y = q[65]; o.z = q[130]; o.w = q[195];
            *(GAS v4u*)(d.dst + (size_t)(d.drow0 + n) * d.K + d.k0 + 16 * c4) = o; }
    } else {
#pragma unroll
        for (int i = 0; i < 8; ++i) { LAS unsigned* q = scr + (4 * i + lr) * 65 + lc;
#pragma unroll
            for (int c = 0; c < 4; ++c) q[c] = pg8::cvt_pk_bf16(v[2 * i][c], v[2 * i + 1][c]); }
        LDS_WAIT(); asm volatile("" ::: "memory");
        const int c8 = lane & 7, nn = lane >> 3;
#pragma unroll
        for (int j = 0; j < 8; ++j) { const int n = nn + 8 * j; const LAS unsigned* q = scr + (4 * c8) * 65 + n;
            v4u o; o.x = q[0]; o.y = q[65]; o.z = q[130]; o.w = q[195];
            const int nd = d.perm ? 128 * ((n >> 4) & 1) + (n & 15) + 16 * (n >> 5) : n;
            *(GAS v4u*)(d.dst + ((size_t)(d.drow0 + nd) * d.K + d.k0 + 8 * c8) * 2) = o; }
    }
    LDS_WAIT(); asm volatile("" ::: "memory");
}
__device__ __forceinline__ void tr_fill(TrDesc& d, const float* W, int K, int N, void* WT, int mode, int item, int f8, float scale) {
    const int nblk = N / 64, kb = item / nblk, nb = item % nblk, n0 = 64 * nb;
    d.src = W; d.dst = (unsigned char*)WT; d.N = N; d.K = K; d.k0 = 64 * kb; d.n0 = n0; d.f8 = f8; d.scale = scale; d.perm = 0;
    d.drow0 = mode == 0 ? n0 : ((n0 >> 7) << 8) + (n0 & 127) + (mode == 2 ? 128 : 0);
    if (mode == 3 && nb < 20) { d.perm = 1; d.drow0 = 256 * (nb >> 2) + 32 * (nb & 3); }
    else if (mode == 3) d.drow0 = n0;
}

#ifndef MOE_ALIGN
#define MOE_ALIGN PG8_ALIGN
#endif
#ifndef PROBE
#define PROBE 0
#endif
#if PROBE
#define PROBE_REP(n) for (int rep_ = 0; rep_ < ((PROBE == (n)) ? 2 : 1); ++rep_)
#else
#define PROBE_REP(n) if constexpr (constexpr int rep_ = 0; true)
#endif
struct Args { const float* in[16]; float* out; unsigned char* ws; };
enum { I_X = 0, I_NG, I_NAQKV, I_RPB, I_NAO, I_GQKV, I_QN, I_KN, I_GO, I_FG, I_FU, I_FD, I_RT, I_MG, I_MU, I_MD };

__global__ void __launch_bounds__(NWAVES * 64, 2) fwd_kernel(Args args) {
    extern __shared__ __attribute__((aligned(16))) unsigned char lds[];
    Frame F;
    F.lds = (LAS unsigned char*)lds;
    F.MISC = (volatile LAS unsigned*)(F.lds + LDSCTL_OFF);
    F.tid = threadIdx.x; F.lane = F.tid & 63; F.wave = __builtin_amdgcn_readfirstlane(F.tid >> 6);
    F.G = gridDim.x; { const int bx = blockIdx.x; F.vcu = (F.G % 8 == 0) ? (bx % 8) * (F.G / 8) + bx / 8 : bx; }
    F.ws = args.ws; F.ctl = (gu32*)(args.ws + WS_CTL);
    unsigned char* const ws = args.ws;
    for (int u = F.tid; u < MISC_WORDS; u += NWAVES * 64) F.MISC[u] = 0u;
    __syncthreads();
    XcdBarrier bar = xcd_barrier_post((unsigned*)(F.ctl + CW_BAR), F.MISC + MW_BAR);
#define GRID_BAR() xcd_barrier(bar)

    const float* x = args.in[I_X]; const float* norm_g = args.in[I_NG]; float* out = args.out;
    bf16* XN = (bf16*)(ws + WS_XN); bf16* QB = (bf16*)(ws + WS_Q); bf16* KB = (bf16*)(ws + WS_K); bf16* VB = (bf16*)(ws + WS_V); bf16* PO = (bf16*)(ws + WS_PO); bf16* HB = PO;
    bf16* ACT = (bf16*)(ws + WS_ACT); unsigned char* XN8 = ws + WS_XN8; unsigned char* APERM = ws + WS_APERM; unsigned char* MACT = ws + WS_MACT; unsigned char* Y8 = ws + WS_Y; bf16* YP = (bf16*)(ws + WS_YP);
    int* tok_e = (int*)(ws + WS_TOKE); float* tok_g = (float*)(ws + WS_TOKG); int* slot_of = (int*)(ws + WS_SLOT); int* ccnt = (int*)(ws + WS_CCNT);
    float* rope_tab = (float*)(ws + WS_ROPE); float* RS0 = (float*)(ws + WS_RS); float* RS1 = RS0 + M; float* RS2 = RS1 + M;
    const int NGW = F.G * NWAVES;
    constexpr int I_A = 16 * 48, I_B = 16 * 16, I_C = 16 * 24, I_D = 16 * 16, I_E = 16 * 56, I_F = 56 * 16;
    constexpr int NDENSE = I_A + I_B + I_C + I_D + 2 * I_E + I_F, NGU = NE * 2 * I_E;
    constexpr int SJ_NPIECE = NE * 2 * (FF / 32) * (D / attn_body::SJ_PK), SJ_CNT = SJ_NPIECE / (256 * NWAVES), SJ_LDS = attn_body::ATTN_LDS_BYTES;
    static_assert(SJ_CNT * 256 * NWAVES == SJ_NPIECE && SJ_CNT % 16 == 0 && SJ_CNT + 3 <= SEQ / 64 - 6 && attn_body::SJ_K == D && attn_body::SJ_N == FF && SJ_LDS + NWAVES * attn_body::SJ_STAGE <= LDSCTL_OFF, "side job");
    const bool side_on = F.G == 256;
    const bool side_real = side_on && attn_body::SJ_MODE == 0;
#define PHASE_IDS() int lane = F.tid & 63; asm volatile("" : "+v"(lane)); const int wave = F.wave; const int colb = 4 * lane; const int gw = F.vcu * NWAVES + wave

    PROBE_REP(100) {
    {
        PHASE_IDS();
        LAS unsigned* scr = (LAS unsigned*)(F.lds + RING_OFF + wave * SCR_WAVE);
#define TR_DECODE_BF(d, it_) do { int r = (it_); \
            if (r < I_A) { tr_fill(d, args.in[I_NAQKV], D, NQKV0, ws + WS_WQKV0, 0, r, 0, 1.f); break; } r -= I_A; \
            if (r < I_B) { tr_fill(d, args.in[I_NAO], D, D, ws + WS_WO0, 0, r, 0, 1.f); break; } r -= I_B; \
            if (r < I_C) { tr_fill(d, args.in[I_GQKV], D, NQKV1, ws + WS_WQKV1, 3, r, 0, 1.f); break; } r -= I_C; \
            if (r < I_D) { tr_fill(d, args.in[I_GO], D, D, ws + WS_WO1, 0, r, 0, 1.f); break; } r -= I_D; \
            if (r < I_E) { tr_fill(d, args.in[I_FG], D, FF, ws + WS_WGU0, 1, r, 0, 1.f); break; } r -= I_E; \
            if (r < I_E) { tr_fill(d, args.in[I_FU], D, FF, ws + WS_WGU0, 2, r, 0, 1.f); break; } r -= I_E; \
            tr_fill(d, args.in[I_FD], FF, D, ws + WS_WD0, 0, r, 0, 1.f); } while (0)
#define TR_DECODE_F8(d, it_) do { int r = (it_); \
            if (r < NGU) { const int e = r / (2 * I_E), q = r % (2 * I_E), up = q >= I_E ? 1 : 0; \
                tr_fill(d, (up ? args.in[I_MU] : args.in[I_MG]) + (size_t)e * D * FF, D, FF, ws + WS_WGUM + (size_t)e * 2 * FF * D, 1 + up, q - up * I_E, 1, WGU_SCALE); break; } r -= NGU; \
            { const int e = r / I_F; tr_fill(d, args.in[I_MD] + (size_t)e * FF * D, FF, D, ws + WS_WDM + (size_t)e * D * FF, 0, r % I_F, 1, WD_SCALE); } } while (0)
#define TR_LOOP(F8_, DEC, NIT, IT0, STRIDE) do { int it = (IT0); TrDesc dA, dB; f32x4 vA[16], vB[16]; bool hA = it < (NIT); \
            if (hA) { DEC(dA, it); tr_load<F8_>(dA, vA, lane); } \
            while (hA) { \
                const int i1 = it + (STRIDE); const bool hB = i1 < (NIT); \
                { DEC(dB, hB ? i1 : it); tr_load<F8_>(dB, vB, lane); }     \
                tr_store<F8_>(dA, vA, scr, lane); \
                if (!hB) break; \
                const int i2 = i1 + (STRIDE); hA = i2 < (NIT); \
                { DEC(dA, hA ? i2 : i1); tr_load<F8_>(dA, vA, lane); } \
                tr_store<F8_>(dB, vB, scr, lane); \
                it = i2; \
            } } while (0)
        TR_LOOP(false, TR_DECODE_BF, NDENSE, gw, NGW);
        if (!side_real) TR_LOOP(true, TR_DECODE_F8, NGU, (gw + NGW - (NDENSE % NGW)) % NGW, NGW);
#undef TR_DECODE_BF
        for (int id = (int)blockIdx.x * (NWAVES * 64) + F.tid; id < 128 * 16; id += F.G * NWAVES * 64) {
            const int pos = id >> 4, i = id & 15; const float fr = exp2f(-(float)i * (13.287712379549449f / 16.0f)); const float ang = (float)pos * fr;
            rope_tab[2 * id] = cosf(ang); rope_tab[2 * id + 1] = sinf(ang);
        }
        f32x4 g0[4];
#pragma unroll
        for (int j = 0; j < 4; ++j) g0[j] = *(const GAS f32x4*)(norm_g + 0 * D + colb + 256 * j);
        {
#define XN_LOAD(V_, m_) do { _Pragma("unroll") for (int j = 0; j < 4; ++j) V_[j] = *(const GAS f32x4*)(x + (size_t)(m_) * D + colb + 256 * j); } while (0)
#define XN_DO(V_, m_) do { const float r = rms_scale(ssq4(V_), D); if (lane == 0) RS0[(m_)] = 1.0f / r; _Pragma("unroll") for (int j = 0; j < 4; ++j) st_bf16x4(XN + (size_t)(m_) * D + colb + 256 * j, V_[j] * r * g0[j]); } while (0)
            f32x4 vA[4], vB[4]; int m = gw; bool hA = m < M;
            if (hA) XN_LOAD(vA, m);
            while (hA) {
                const int m1 = m + NGW; const bool hB = m1 < M; XN_LOAD(vB, hB ? m1 : m);
                XN_DO(vA, m);
                if (!hB) break;
                const int m2 = m1 + NGW; hA = m2 < M; XN_LOAD(vA, hA ? m2 : m1);
                XN_DO(vB, m1);
                m = m2;
            }
#undef XN_LOAD
#undef XN_DO
        }
    }
    GRID_BAR();
    }

    PROBE_REP(1) {
    {
        pg8::Gemm g{XN, (const bf16*)(ws + WS_WQKV0), M, NQKV0, D, 0}; pg8::StaticOrder S; S.init(M, NQKV0, F.G, (int)blockIdx.x);
        pg8::EpiBf16<0> E{QB, D, nullptr, D, (size_t)(WS_K - WS_Q) / 2, attn_body::C2};
        pg8::gemm_phase<pg8::EpiBf16<0>, pg8::StaticOrder, PG8_ALIGN, PG8_SP2>(F.lds + RING_OFF, g, S, E);
    }
    GRID_BAR();
    }

    PROBE_REP(2) {
    {
        attn_body::lds_fptr tab = (attn_body::lds_fptr)(F.lds + NA_TAB_OFF);
        const int upc = (1024 + F.G - 1) / F.G; int cur_h = -1;
        for (int i = 0; i < upc; ++i) {
            const int id = F.vcu * upc + i; if (id >= 1024) break;
            const int bh = id >> 5, qb4 = id & 31, b = bh >> 4, h = bh & 15, r0 = 4 * qb4;
            if (h != cur_h) {
                const float* rp = args.in[I_RPB] + (size_t)h * 15 * 31;
                LAS float* raw = (LAS float*)(F.lds + NA_TAB_OFF) + 4 * attn_body::NA_TCOPY;
                if (F.tid < 15 * 31) raw[F.tid] = rp[F.tid] * LOG2E;
                LDS_WAIT(); __syncthreads();
                for (int u = F.tid; u < 4 * attn_body::NA_TCOPY; u += NWAVES * 64) { const int s = u / attn_body::NA_TCOPY, rem = u % attn_body::NA_TCOPY, ro = rem / attn_body::NA_TROW, x = rem % attn_body::NA_TROW - s, dc = x - 64;
                    const float v = (x >= 0 && dc >= -15 && dc <= 15) ? raw[ro * 31 + dc + 15] : 0.f;
                    ((LAS float*)(F.lds + NA_TAB_OFF))[u] = v; }
                cur_h = h; LDS_WAIT(); __syncthreads();
            }
            int first = r0 - 4; first = first < 0 ? 0 : (first > 117 ? 117 : first);
            attn_body::attn_unit<1, 1024, 1024, 8, false, true>(b, h, h, 64 * r0, 64 * first, 11, (const attn_body::bf16*)QB, (const attn_body::bf16*)KB, (const attn_body::bf16*)VB, (attn_body::bf16*)((PROBE == 2 && rep_ == 0) ? ACT : QB), (char*)lds + RING_OFF, r0, first, tab);
        }
    }
    GRID_BAR();
    }

    PROBE_REP(3) {
    {
        pg8::Gemm g{QB, (const bf16*)(ws + WS_WO0), M, D, D, 0}; pg8::StaticOrder S; S.init(M, D, F.G, (int)blockIdx.x);
        pg8::EpiBf16<0> E{PO, D, nullptr, 0, 0, 1.f};
        pg8::gemm_phase<pg8::EpiBf16<0>, pg8::StaticOrder, PG8_ALIGN, PG8_SP2>(F.lds + RING_OFF, g, S, E);
    }
    GRID_BAR();
    }

#define THIN_LOAD(P_, H_, S_, ABUF, HF32, RSIN, m_) do { _Pragma("unroll") for (int j = 0; j < 4; ++j) { P_[j] = ld_bf16x4((ABUF) + (size_t)(m_) * D + colb + 256 * j); \
            if constexpr (HF32) H_[j] = *(const GAS f32x4*)(x + (size_t)(m_) * D + colb + 256 * j); else H_[j] = ld_bf16x4(XN + (size_t)(m_) * D + colb + 256 * j); } \
            if constexpr (!(HF32)) S_ = (RSIN)[(m_)]; } while (0)
#define THIN_DO(P_, H_, S_, HF32, RSOUT, m_) do { const float r1 = rms_scale(ssq4(P_), D); \
            if constexpr (!(HF32)) { _Pragma("unroll") for (int j = 0; j < 4; ++j) H_[j] = H_[j] * (igb[j] * S_); }     \
            _Pragma("unroll") for (int j = 0; j < 4; ++j) H_[j] = H_[j] + P_[j] * r1 * ga[j]; \
            const float r2 = rms_scale(ssq4(H_), D); if (lane == 0) (RSOUT)[(m_)] = 1.0f / r2; \
            _Pragma("unroll") for (int j = 0; j < 4; ++j) st_bf16x4(XN + (size_t)(m_) * D + colb + 256 * j, H_[j] * r2 * gb[j]); } while (0)
#define THIN_RES_NORM(ABUF, HF32, GA, GB, GPREV, RSIN, RSOUT) do { \
        PHASE_IDS(); f32x4 ga[4], gb[4], igb[4]; \
        _Pragma("unroll") for (int j = 0; j < 4; ++j) { ga[j] = *(const GAS f32x4*)((GA) + colb + 256 * j); gb[j] = *(const GAS f32x4*)((GB) + colb + 256 * j); \
            if constexpr (!(HF32)) { const f32x4 gp = *(const GAS f32x4*)((GPREV) + colb + 256 * j); igb[j] = (f32x4){1.0f / gp.x, 1.0f / gp.y, 1.0f / gp.z, 1.0f / gp.w}; } else igb[j] = (f32x4){0.f, 0.f, 0.f, 0.f}; } \
        f32x4 pA[4], hA_[4], pB[4], hB_[4]; float sA = 0.f, sB = 0.f; int m = gw; const int m0_ = gw; bool hasA = m < M; \
        if (hasA) THIN_LOAD(pA, hA_, sA, ABUF, HF32, RSIN, m); \
        while (hasA) {                                                     \
            const int m1 = m + NGW; const bool hasB = m1 < M; THIN_LOAD(pB, hB_, sB, ABUF, HF32, RSIN, hasB ? m1 : m0_);     \
            THIN_DO(pA, hA_, sA, HF32, RSOUT, m); \
            if (!hasB) break; \
            const int m2 = m1 + NGW; hasA = m2 < M; THIN_LOAD(pA, hA_, sA, ABUF, HF32, RSIN, hasA ? m2 : m0_); \
            THIN_DO(pB, hB_, sB, HF32, RSOUT, m1); \
            m = m2; \
        } } while (0)

    THIN_RES_NORM(PO, false, norm_g + 1 * D, norm_g + 2 * D, norm_g + 0 * D, RS0, RS1);
    GRID_BAR();

    PROBE_REP(5) {
    {
        pg8::Gemm g{XN, (const bf16*)(ws + WS_WGU0), M, 2 * FF, D, 0}; pg8::StaticOrder S; S.init(M, 2 * FF, F.G, (int)blockIdx.x);
        pg8::EpiSwiglu E{ACT, FF};
        pg8::gemm_phase<pg8::EpiSwiglu, pg8::StaticOrder, PG8_ALIGN, PG8_SP2>(F.lds + RING_OFF, g, S, E);
    }
    GRID_BAR();
    }

    PROBE_REP(6) {
    {
        pg8::Gemm g{ACT, (const bf16*)(ws + WS_WD0), M, D, FF, 0}; pg8::StaticOrder S; S.init(M, D, F.G, (int)blockIdx.x);
        pg8::EpiBf16<0> E{QB, D, nullptr, 0, 0, 1.f};
        pg8::gemm_phase<pg8::EpiBf16<0>, pg8::StaticOrder, PG8_ALIGN, PG8_SP2>(F.lds + RING_OFF, g, S, E);
    }
    GRID_BAR();
    }

    THIN_RES_NORM(QB, false, norm_g + 3 * D, norm_g + 4 * D, norm_g + 2 * D, RS1, RS2);
    GRID_BAR();

    PROBE_REP(8) {
    {
        pg8::Gemm g{XN, (const bf16*)(ws + WS_WQKV1), M, NQKV1, D, 0}; pg8::StaticOrder S; S.init(M, NQKV1, F.G, (int)blockIdx.x);
        pg8::EpiQkvRope E{QB, (size_t)(WS_K - WS_Q) / 2, args.in[I_QN], args.in[I_KN], rope_tab, attn_body::C2, EPS};
        pg8::gemm_phase<pg8::EpiQkvRope, pg8::StaticOrder, PG8_ALIGN, PG8_SP2>(F.lds + RING_OFF, g, S, E);
        {
            PHASE_IDS(); (void)colb; (void)gw;
            LAS unsigned* scr = (LAS unsigned*)(F.lds + RING_OFF + wave * SCR_WAVE);
            const int nun = (M / 256) * (NQKV1 / 256), rem = nun % F.G, first = rem == 0 ? 0 : rem, nidle = F.G - first;
            const int me = (int)blockIdx.x - first;
            if (me >= 0) { const int stride = nidle * NWAVES; TR_LOOP(true, TR_DECODE_F8, NGU + NE * I_F, NGU + me * NWAVES + wave, stride); }
        }
    }
    GRID_BAR();
    }
#undef TR_DECODE_F8
#undef TR_LOOP

    PROBE_REP(10) {
    {
        float gq = fabsf(args.in[I_QN][F.tid & 63]), gk = fabsf(args.in[I_KN][F.tid & 63]);
#pragma unroll
        for (int o = 1; o < 64; o <<= 1) { gq = fmaxf(gq, __shfl_xor(gq, o)); gk = fmaxf(gk, __shfl_xor(gk, o)); }
        const bool nomax = __builtin_amdgcn_readfirstlane((64.0f * 1.01f * 0.125f * LOG2E) * gq * gk < 64.0f ? 1 : 0) != 0;
        const int upc = (1024 + F.G - 1) / F.G;
        for (int i = 0; i < upc; ++i) {
            const int id = F.vcu * upc + i; if (id >= 1024) break;
            const int bk = id >> 7, loc = id & 127, b = bk >> 2, hk = bk & 3, hq = 4 * hk + (loc >> 5), qb = loc & 31;
            attn_body::bf16* Od = (attn_body::bf16*)((PROBE == 10 && rep_ == 0) ? ACT : QB);
#define GQA_UNIT(NM_, SD_) attn_body::attn_unit<0, 1024, 256, 8, NM_, false, SD_>(b, hq, hk, 256 * qb, 0, SEQ / 64, (const attn_body::bf16*)QB, (const attn_body::bf16*)KB, (const attn_body::bf16*)VB, Od, (char*)lds + RING_OFF, 0, 0, (attn_body::lds_fptr)(F.lds + NA_TAB_OFF), sj)
            const attn_body::SideJob sj{args.in[I_MG], args.in[I_MU], attn_body::SJ_MODE == 0 ? ws + WS_WGUM : ws + WS_ACT, F.vcu * NWAVES * SJ_CNT, SJ_CNT, (unsigned)(uintptr_t)((char*)lds + RING_OFF + SJ_LDS), WGU_SCALE};
            if (side_on && i == 0) { if (nomax) GQA_UNIT(true, true); else GQA_UNIT(false, true); }
            else { if (nomax) GQA_UNIT(true, false); else GQA_UNIT(false, false); }
#undef GQA_UNIT
        }
    }
    GRID_BAR();
    }

    {
        pg8::Gemm g{QB, (const bf16*)(ws + WS_WO1), M, D, D, 0}; pg8::StaticOrder S; S.init(M, D, F.G, (int)blockIdx.x);
        pg8::EpiBf16<0> E{KB, D, nullptr, 0, 0, 1.f};
        pg8::gemm_phase<pg8::EpiBf16<0>, pg8::StaticOrder, PG8_ALIGN, PG8_SP2>(F.lds + RING_OFF, g, S, E);
    }
    GRID_BAR();

    {
        PHASE_IDS();
        LAS float* wrT = (LAS float*)(F.lds + RING_OFF);
        { float t_[D * NE / (NWAVES * 64)];
#pragma unroll
            for (int i = 0; i < D * NE / (NWAVES * 64); ++i) t_[i] = args.in[I_RT][F.tid + NWAVES * 64 * i];
#pragma unroll
            for (int i = 0; i < D * NE / (NWAVES * 64); ++i) { const int u = F.tid + NWAVES * 64 * i; wrT[(u & 7) * D + (u >> 3)] = t_[i]; } }
        f32x4 ga[4], gb[4];
#pragma unroll
        for (int j = 0; j < 4; ++j) { ga[j] = *(const GAS f32x4*)(norm_g + 5 * D + colb + 256 * j); gb[j] = *(const GAS f32x4*)(norm_g + 6 * D + colb + 256 * j); }
        f32x4 igp[4];
#pragma unroll
        for (int j = 0; j < 4; ++j) { const f32x4 gp = *(const GAS f32x4*)(norm_g + 4 * D + colb + 256 * j); igp[j] = (f32x4){1.0f / gp.x, 1.0f / gp.y, 1.0f / gp.z, 1.0f / gp.w}; }
        LDS_WAIT(); __syncthreads();
        for (int c = (int)blockIdx.x; c < NCHUNK; c += F.G) {
            if (F.tid < NE) F.MISC[MW_CNT + F.tid] = 0u;
            __syncthreads();
#define P12_LOAD(P_, H_, S_, m_) do { _Pragma("unroll") for (int j = 0; j < 4; ++j) { P_[j] = ld_bf16x4(KB + (size_t)(m_) * D + colb + 256 * j); H_[j] = ld_bf16x4(XN + (size_t)(m_) * D + colb + 256 * j); } S_ = RS2[(m_)]; } while (0)
#define P12_DO(p, hv, s_, m_) do { const int m = (m_); \
                const float r1 = rms_scale(ssq4(p), D); \
                _Pragma("unroll") for (int j = 0; j < 4; ++j) hv[j] = hv[j] * (igp[j] * s_);                            \
                _Pragma("unroll") for (int j = 0; j < 4; ++j) { hv[j] = hv[j] + p[j] * r1 * ga[j]; st_bf16x4(HB + (size_t)m * D + colb + 256 * j, hv[j]); } \
                const float r2 = rms_scale(ssq4(hv), D); \
                _Pragma("unroll") for (int j = 0; j < 4; ++j) { hv[j] = hv[j] * r2 * gb[j]; *(GAS unsigned*)(XN8 + (size_t)m * D + colb + 256 * j) = pg8::cvt4_fp8(hv[j].x, hv[j].y, hv[j].z, hv[j].w); } \
                float lg[NE]; \
                _Pragma("unroll") for (int e = 0; e < NE; ++e) { float a = 0.f; \
                    _Pragma("unroll") for (int j = 0; j < 4; ++j) { const f32x4 w = *(const LAS f32x4*)(wrT + e * D + colb + 256 * j); a += (hv[j].x * w.x + hv[j].y * w.y) + (hv[j].z * w.z + hv[j].w * w.w); } \
                    lg[e] = wave_sum(a); } \
                int e0 = 0; float v0 = lg[0]; \
                _Pragma("unroll") for (int e = 1; e < NE; ++e) if (lg[e] > v0) { v0 = lg[e]; e0 = e; } \
                int e1 = -1; float v1 = -3.0e38f; \
                _Pragma("unroll") for (int e = 0; e < NE; ++e) if (e != e0 && lg[e] > v1) { v1 = lg[e]; e1 = e; } \
                if (e1 < 0) e1 = (e0 + 1) & 7;                                 \
                const float g0 = 1.0f / (1.0f + __expf(v1 - v0)), g1 = 1.0f - g0; \
                if (lane == 0) { tok_e[2 * m] = e0; tok_e[2 * m + 1] = e1; tok_g[2 * m] = g0; tok_g[2 * m + 1] = g1; \
                    __hip_atomic_fetch_add((LAS unsigned*)(F.lds + LDSCTL_OFF) + MW_CNT + e0, 1u, __ATOMIC_RELAXED, __HIP_MEMORY_SCOPE_WORKGROUP); \
                    __hip_atomic_fetch_add((LAS unsigned*)(F.lds + LDSCTL_OFF) + MW_CNT + e1, 1u, __ATOMIC_RELAXED, __HIP_MEMORY_SCOPE_WORKGROUP); } } while (0)
            {
                const int mb = 64 * c + 8 * wave; f32x4 pA[4], hA_[4], pB[4], hB_[4]; float sA, sB;
                P12_LOAD(pA, hA_, sA, mb);
#pragma unroll
                for (int i = 0; i < 8; i += 2) {
                    P12_LOAD(pB, hB_, sB, mb + i + 1);
                    P12_DO(pA, hA_, sA, mb + i);
                    P12_LOAD(pA, hA_, sA, mb + (i + 2 < 8 ? i + 2 : 0));
                    P12_DO(pB, hB_, sB, mb + i + 1);
                }
            }
#undef P12_LOAD
#undef P12_DO
            LDS_WAIT(); __syncthreads();
            if (F.tid < NE) ccnt[c * NE + F.tid] = (int)F.MISC[MW_CNT + F.tid];
            __syncthreads();
        }
    }
    GRID_BAR();

    PROBE_REP(13) {
    {
        PHASE_IDS();
        LAS int* cn = (LAS int*)(F.lds + RING_OFF);
        LAS int* ps = cn + NCHUNK * NE;
        LAS int* pre = ps + 64 * NE;
        LAS int* tot = pre + 64 * NE;
        LAS int* rst = tot + NE;
        LAS int* ent = rst + NE;
        LAS int* slt = ent + 128;
        LAS int* rnk = slt + 128;
        LAS int* w0c = rnk + 128;
        const int c0 = (int)blockIdx.x; int te0 = 0; v4u ar0[8];
        if (c0 < NCHUNK) { if (F.tid < 128) te0 = tok_e[128 * c0 + F.tid];
#pragma unroll
            for (int i = 0; i < 8; ++i) ar0[i] = *(const GAS v4u*)(XN8 + (size_t)(64 * c0 + 8 * wave + i) * D + 16 * lane); }
        { int t_[NCHUNK * NE / (NWAVES * 64)];
#pragma unroll
            for (int i = 0; i < NCHUNK * NE / (NWAVES * 64); ++i) t_[i] = ccnt[F.tid + NWAVES * 64 * i];
#pragma unroll
            for (int i = 0; i < NCHUNK * NE / (NWAVES * 64); ++i) cn[F.tid + NWAVES * 64 * i] = t_[i]; }
        LDS_WAIT(); __syncthreads();
        { const int e = F.tid & 7, part = F.tid >> 3; ps[part * NE + e] = (cn[(4 * part + 0) * NE + e] + cn[(4 * part + 1) * NE + e]) + (cn[(4 * part + 2) * NE + e] + cn[(4 * part + 3) * NE + e]); }
        LDS_WAIT(); __syncthreads();
        { const int v = ps[lane * NE + wave]; int inc = v;
#pragma unroll
            for (int o = 1; o < 64; o <<= 1) { const int nb_ = __shfl_up(inc, o); if (lane >= o) inc += nb_; }
            pre[lane * NE + wave] = inc - v; if (lane == 63) tot[wave] = inc; }
        LDS_WAIT(); __syncthreads();
        if (F.tid == 0) { int ts = 0; for (int e = 0; e < NE; ++e) { F.MISC[MW_TS + e] = (unsigned)ts; rst[e] = ts * 256; ts += (tot[e] + 255) >> 8; } F.MISC[MW_TS + NE] = (unsigned)ts; }
        LDS_WAIT(); __syncthreads();
        for (int c = (int)blockIdx.x; c < NCHUNK; c += F.G) {
            if (F.tid < 128) ent[F.tid] = c == c0 ? te0 : tok_e[128 * c + F.tid];
            LDS_WAIT(); __syncthreads();
            if (F.tid < 128) {
                const int e = ent[F.tid]; int rank = 0;
#pragma unroll
                for (int x = 0; x < NE; ++x) { const unsigned long long mk = __ballot(e == x); if (e == x) rank = __builtin_popcountll(mk & ((1ull << lane) - 1ull)); if (wave == 0 && lane == 0) w0c[x] = __builtin_popcountll(mk); }
                rnk[F.tid] = rank; }
            LDS_WAIT(); __syncthreads();
            if (F.tid < 128) { const int e = ent[F.tid]; const int rank = rnk[F.tid] + (F.tid >= 64 ? w0c[e] : 0);
                int base = rst[e] + pre[(c >> 2) * NE + e]; for (int q = 4 * (c >> 2); q < c; ++q) base += cn[q * NE + e];
                slt[F.tid] = base + rank; slot_of[128 * c + F.tid] = base + rank; }
            LDS_WAIT(); __syncthreads();
#pragma unroll
            for (int i = 0; i < 8; ++i) { const int rr = 8 * wave + i, m = 64 * c + rr; const int s0 = slt[2 * rr], s1 = slt[2 * rr + 1];
                v4u a = ar0[i]; if (c != c0) a = *(const GAS v4u*)(XN8 + (size_t)m * D + 16 * lane);
                *(GAS v4u*)(APERM + (size_t)s0 * D + 16 * lane) = a; *(GAS v4u*)(APERM + (size_t)s1 * D + 16 * lane) = a; }
            LDS_WAIT(); __syncthreads();
        }
    }
    GRID_BAR();
    }

    PROBE_REP(14) {
    {
        const int ntile = (int)F.MISC[MW_TS + NE];
        pg8::Gemm g{(const bf16*)APERM, (const bf16*)(ws + WS_WGUM), ntile * 256, 2 * FF, D / 2, (size_t)2 * FF * D}; pg8::MoeOrder S; S.init(ntile * 256, 2 * FF, F.G, (int)blockIdx.x); S.ts = (const volatile LAS int*)(F.MISC + MW_TS);
        pg8::EpiSwigluF8 E{MACT, FF, 1.0f / WGU_SCALE};
        pg8::gemm_phase<pg8::EpiSwigluF8, pg8::MoeOrder, MOE_ALIGN, PG8_SP2, true>(F.lds + RING_OFF, g, S, E);
    }
    GRID_BAR();
    }

    PROBE_REP(16) {
    {
        const int ntile = (int)F.MISC[MW_TS + NE];
        pg8::Gemm g{(const bf16*)MACT, (const bf16*)(ws + WS_WDM), ntile * 256, D, FF / 2, (size_t)D * FF}; pg8::MoeOrder S; S.init(ntile * 256, D, F.G, (int)blockIdx.x); S.ts = (const volatile LAS int*)(F.MISC + MW_TS);
        pg8::EpiF8Scale E{Y8, D, Y8_SCALE / WD_SCALE};
        const int pmfull = ((ntile * (D / 256)) / F.G) * F.G / (D / 256), nleft = (ntile - pmfull) * (D / 256); const bool split = pmfull > 0 && nleft > 0 && nleft * P16_KS <= F.G && F.G % (D / 256) == 0;
        if (split) S.init(pmfull * 256, D, F.G, (int)blockIdx.x);
        pg8::gemm_phase<pg8::EpiF8Scale, pg8::MoeOrder, PG8_ALIGN, PG8_SP2, true>(F.lds + RING_OFF, g, S, E);
        if (split) {
            pg8::Gemm g2 = g; g2.ntk = FF / 128 / P16_KS;
            pg8::SplitKOrder S2; S2.init(ntile * 256, D, F.G, (int)blockIdx.x); S2.ts = (const volatile LAS int*)(F.MISC + MW_TS); S2.pm0 = pmfull; S2.KS = P16_KS; S2.kpart = FF / P16_KS; S2.ntot = nleft * P16_KS;
            pg8::EpiBf16Part E2{YP, 1.0f / WD_SCALE};
            pg8::gemm_phase<pg8::EpiBf16Part, pg8::SplitKOrder, PG8_ALIGN, PG8_SP2, true>(F.lds + RING_OFF, g2, S2, E2);
        }
    }
    GRID_BAR();
    }

    PROBE_REP(17) {
    {
        PHASE_IDS();
        f32x4 ga[4];
#pragma unroll
        for (int j = 0; j < 4; ++j) ga[j] = *(const GAS f32x4*)(norm_g + 7 * D + colb + 256 * j);
        const unsigned bad = __hip_atomic_load((gu32*)((unsigned*)(F.ctl + CW_BAR) + XB_TMO), RLX_AGENT);
        const float qn = bad ? __builtin_nanf("") : 0.f;
        const int nrow = gw < M ? (M - gw + NGW - 1) / NGW : 0;
        const int ntile17 = (int)F.MISC[MW_TS + NE], pmf17 = ((ntile17 * (D / 256)) / F.G) * F.G / (D / 256), nleft17 = (ntile17 - pmf17) * (D / 256);
        const bool split17 = pmf17 > 0 && nleft17 > 0 && nleft17 * P16_KS <= F.G && F.G % (D / 256) == 0; const int pm17 = split17 ? pmf17 : MOE_MAXT + 1;
#define P17_LOAD(Y0_, Y1_, H_, i_) do { const int ii_ = (i_); const int m_ = gw + (base + ii_) * NGW; const int s0 = __builtin_amdgcn_readlane(rs0, ii_), s1 = __builtin_amdgcn_readlane(rs1, ii_); \
            _Pragma("unroll") for (int j = 0; j < 4; ++j) { Y0_[j] = ld_fp8x4(Y8 + (size_t)s0 * D + colb + 256 * j); Y1_[j] = ld_fp8x4(Y8 + (size_t)s1 * D + colb + 256 * j); H_[j] = ld_bf16x4(HB + (size_t)m_ * D + colb + 256 * j); } } while (0)
#define P17_DO(Y0_, Y1_, H_, i_) do { const int ii_ = (i_); const int m_ = gw + (base + ii_) * NGW; \
            const float g0 = __int_as_float(__builtin_amdgcn_readlane(__float_as_int(rg0), ii_)), g1 = __int_as_float(__builtin_amdgcn_readlane(__float_as_int(rg1), ii_)); \
            _Pragma("unroll") for (int j = 0; j < 4; ++j) Y0_[j] = Y0_[j] * g0 + Y1_[j] * g1; \
            const float r = rms_scale(ssq4(Y0_), D); \
            _Pragma("unroll") for (int j = 0; j < 4; ++j) *(GAS f32x4*)(out + (size_t)m_ * D + colb + 256 * j) = H_[j] + Y0_[j] * r * ga[j] + qn; } while (0)
        for (int base = 0; base < nrow; base += 64) {
            const int nb = nrow - base < 64 ? nrow - base : 64;
            int rs0 = 0, rs1 = 0; float rg0 = 0.f, rg1 = 0.f;
            if (lane < nb) { const int mi = gw + (base + lane) * NGW; rs0 = slot_of[2 * mi]; rs1 = slot_of[2 * mi + 1]; rg0 = tok_g[2 * mi] * (1.0f / Y8_SCALE); rg1 = tok_g[2 * mi + 1] * (1.0f / Y8_SCALE); }
            f32x4 yA0[4], yA1[4], hA_[4], yB0[4], yB1[4], hB_[4];
            P17_LOAD(yA0, yA1, hA_, 0);
            for (int i = 0; i < nb; i += 2) {
                P17_LOAD(yB0, yB1, hB_, i + 1 < nb ? i + 1 : 0);
                P17_DO(yA0, yA1, hA_, i);
                if (i + 1 >= nb) break;
                P17_LOAD(yA0, yA1, hA_, i + 2 < nb ? i + 2 : 0);
                P17_DO(yB0, yB1, hB_, i + 1);
            }
            if (split17) {
                const bool late = lane < nb && ((rs0 >> 8) >= pm17 || (rs1 >> 8) >= pm17);
                unsigned long long wm = __ballot(late);
                while (wm) { const int i = __builtin_ctzll(wm); wm &= wm - 1; const int m_ = gw + (base + i) * NGW;
                    const int s0 = __builtin_amdgcn_readlane(rs0, i), s1 = __builtin_amdgcn_readlane(rs1, i);
                    const float g0 = __int_as_float(__builtin_amdgcn_readlane(__float_as_int(rg0), i)), g1 = __int_as_float(__builtin_amdgcn_readlane(__float_as_int(rg1), i));
                    f32x4 y[4], hv[4], a0[4], a1[4]; u32x2 hh[4];
#pragma unroll
                    for (int j = 0; j < 4; ++j) hh[j] = *(const GAS u32x2*)(HB + (size_t)m_ * D + colb + 256 * j);
#define P17_SLOT(A_, s_) do { if (((s_) >> 8) >= pm17) { u32x2 w_[4][P16_KS]; \
                        _Pragma("unroll") for (int j = 0; j < 4; ++j) { const bf16* t_ = YP + ((size_t)(((((s_) >> 8) - pm17) * 4 + j) * P16_KS) * 256 + ((s_) & 255)) * 256 + colb; \
                            _Pragma("unroll") for (int p = 0; p < P16_KS; ++p) w_[j][p] = *(const GAS u32x2*)(t_ + (size_t)p * 65536); } \
                        _Pragma("unroll") for (int j = 0; j < 4; ++j) { f32x4 s4 = (f32x4){0.f, 0.f, 0.f, 0.f}; \
                            _Pragma("unroll") for (int p = 0; p < P16_KS; ++p) s4 += (f32x4){__uint_as_float(w_[j][p].x << 16), __uint_as_float(w_[j][p].x & 0xffff0000u), __uint_as_float(w_[j][p].y << 16), __uint_as_float(w_[j][p].y & 0xffff0000u)}; \
                            A_[j] = s4 * Y8_SCALE; } } \
                    else { int q_[4]; _Pragma("unroll") for (int j = 0; j < 4; ++j) q_[j] = *(const GAS int*)(Y8 + (size_t)(s_) * D + colb + 256 * j); \
                        _Pragma("unroll") for (int j = 0; j < 4; ++j) A_[j] = (f32x4){__builtin_amdgcn_cvt_f32_fp8(q_[j], 0), __builtin_amdgcn_cvt_f32_fp8(q_[j], 1), __builtin_amdgcn_cvt_f32_fp8(q_[j], 2), __builtin_amdgcn_cvt_f32_fp8(q_[j], 3)}; } } while (0)
                    P17_SLOT(a0, s0); P17_SLOT(a1, s1);
#undef P17_SLOT
#pragma unroll
                    for (int j = 0; j < 4; ++j) { y[j] = a0[j] * g0 + a1[j] * g1;
                        hv[j] = (f32x4){__uint_as_float(hh[j].x << 16), __uint_as_float(hh[j].x & 0xffff0000u), __uint_as_float(hh[j].y << 16), __uint_as_float(hh[j].y & 0xffff0000u)}; }
                    const float r = rms_scale(ssq4(y), D);
#pragma unroll
                    for (int j = 0; j < 4; ++j) *(GAS f32x4*)(out + (size_t)m_ * D + colb + 256 * j) = hv[j] + y[j] * r * ga[j] + qn; }
            }
        }
#undef P17_LOAD
#undef P17_DO
    }
    if (PROBE == 17) GRID_BAR();
    }
#undef GRID_BAR
#undef THIN_RES_NORM
#undef THIN_LOAD
#undef THIN_DO
}

extern "C" void kernel_launch(void* const* d_in, const int* in_sizes, int n_in, void* d_out, int out_size, void* d_ws, size_t ws_size, hipStream_t stream) {
    static int grid = 0;
    if (grid == 0) {
        if (n_in != 16 || in_sizes[0] != M * D || out_size != M * D || ws_size < WS_END) { fprintf(stderr, "kernel_launch: built for 16 inputs, x and out of %d floats, >= %zu bytes of workspace; got n_in %d, in0 %d, out %d, ws %zu; nothing launched\n", M * D, (size_t)WS_END, n_in, n_in > 0 ? in_sizes[0] : -1, out_size, ws_size); grid = -1; return; }
        int dev = 0, cus = 0, per_cu = 0;
        if (hipGetDevice(&dev) != hipSuccess || hipDeviceGetAttribute(&cus, hipDeviceAttributeMultiprocessorCount, dev) != hipSuccess) { fprintf(stderr, "kernel_launch: hipGetDevice / hipDeviceGetAttribute failed; nothing launched\n"); grid = -1; return; }
        if (hipFuncSetAttribute((const void*)fwd_kernel, hipFuncAttributeMaxDynamicSharedMemorySize, LDS_BYTES) != hipSuccess) { fprintf(stderr, "kernel_launch: hipFuncSetAttribute failed (%d bytes of dynamic LDS); nothing launched\n", LDS_BYTES); grid = -1; return; }
        if (hipOccupancyMaxActiveBlocksPerMultiprocessor(&per_cu, (const void*)fwd_kernel, NWAVES * 64, LDS_BYTES) != hipSuccess || per_cu < 1) { fprintf(stderr, "kernel_launch: occupancy query reports %d workgroups per CU; nothing launched\n", per_cu); (void)hipGetLastError(); grid = -1; return; }
        grid = cus;
    }
    if (grid < 0) return;
    if (hipMemsetAsync((char*)d_ws + WS_CTL, 0, CTL_ZERO_BYTES, stream) != hipSuccess) { fprintf(stderr, "kernel_launch: hipMemsetAsync of the control words failed; nothing launched\n"); return; }
    Args a{};
    for (int i = 0; i < 16; ++i) a.in[i] = (const float*)d_in[i];
    a.out = (float*)d_out; a.ws = (unsigned char*)d_ws;
    hipLaunchKernelGGL(fwd_kernel, dim3(grid), dim3(NWAVES * 64), LDS_BYTES, stream, a);
    const hipError_t le = hipPeekAtLastError();
    if (le != hipSuccess) fprintf(stderr, "kernel_launch: launch failed: %s (grid %d x %d threads, %d B LDS)\n", hipGetErrorName(le), grid, NWAVES * 64, LDS_BYTES);
}
```

```cpp
#include <hip/hip_runtime.h>
#include <cstdio>
#include <cstdint>
namespace pg8 {
#define PG8_LAS __attribute__((address_space(3)))
typedef unsigned short bf16_t;
typedef short bf16x8 __attribute__((ext_vector_type(8)));
typedef float f32x4 __attribute__((ext_vector_type(4)));
typedef unsigned u32x4 __attribute__((ext_vector_type(4)));
typedef int i32x4 __attribute__((ext_vector_type(4)));
typedef int i32x8 __attribute__((ext_vector_type(8)));
typedef unsigned u32x2 __attribute__((ext_vector_type(2)));
constexpr int BM = 256, BK = 64, HALF = 128, HTB = HALF * BK * 2  , STAGE_BYTES = 8 * HTB, NXCD = 8, WGM = 8;

__host__ __device__ __forceinline__ int lds_byte(int r, int c) { const int st = (r >> 4) * 2 + (c >> 5), rr = r & 15, cc = c & 31, ob = rr * 64 + cc * 2; return st * 1024 + (ob ^ (((ob >> 9) & 1) << 5)); }
__host__ __device__ __forceinline__ void stage_rc(int b, int& R, int& C) { const int st = b / 1024, sb = b % 1024, swz = sb ^ (((sb >> 9) & 1) << 5); R = (st >> 1) * 16 + swz / 64; C = (st & 1) * 32 + (swz % 64) / 2; }
__host__ __device__ __forceinline__ int perm32(int rho) { const int n = rho >> 4, i = rho & 15; return 8 * (i >> 2) + 4 * n + (i & 3); }

struct Unit { int pm, pn, eb, kb, po; };
struct Gemm { const bf16_t* A; const bf16_t* Bt; int M, N, K; size_t bstride; int ntk; };

struct StaticOrder {
    int nM, nN, nwg, G, c, nlim;
    __host__ __device__ void init(int M, int N, int G_, int c_) { nM = M / BM; nN = N / BM; nwg = nM * nN; G = G_; c = c_; nlim = nwg; }
    __host__ __device__ __forceinline__ bool next(int i, Unit& u) const { const long L = (long)i * G + c; if (L >= nlim) return false; at((int)L, u); return true; }
    __host__ __device__ __forceinline__ void at(int L, Unit& u) const {
        int wgid = L; { const int q = nwg / NXCD, r = nwg % NXCD, xcd = wgid % NXCD, off = wgid / NXCD; wgid = (xcd < r ? xcd * (q + 1) : r * (q + 1) + (xcd - r) * q) + off; }
        const int nig = WGM * nN, gid = wgid / nig, fm = gid * WGM, gsz = (nM - fm) < WGM ? (nM - fm) : WGM;
        u.pm = fm + ((wgid % nig) % gsz); u.pn = (wgid % nig) / gsz; u.eb = 0; u.kb = 0; u.po = 0;
    }
    __device__ __forceinline__ void a_ready(const Unit&) const {}
    __device__ __forceinline__ void done(const Unit&) const {}
};

__device__ __forceinline__ unsigned cvt_pk_bf16(float lo, float hi) { unsigned r; asm volatile("v_cvt_pk_bf16_f32 %0, %1, %2" : "=v"(r) : "v"(lo), "v"(hi)); return r; }
typedef float f32x2 __attribute__((ext_vector_type(2)));
__device__ __forceinline__ f32x2 gelu_pk(f32x2 v) {
    const f32x2 av = __builtin_elementwise_abs(v), d = av * 0.2316418882f + 1.0f;
    f32x2 t; t.x = __builtin_amdgcn_rcpf(d.x); t.y = __builtin_amdgcn_rcpf(d.y);
    f32x2 q = t * 0.5307027145f + (-0.7265760135f); q = q * t + 0.7107068705f; q = q * t + (-0.142248368f); q = q * t + 0.127414796f; q = q * t;
    const f32x2 s = (v * v) * (-0.72134752044f);
    f32x2 e; e.x = __builtin_amdgcn_exp2f(s.x); e.y = __builtin_amdgcn_exp2f(s.y);
    const f32x2 m = v * (q * e), r = v - m;
    f32x2 o; o.x = v.x < 0.f ? m.x : r.x; o.y = v.y < 0.f ? m.y : r.y; return o;
}

template <int ACT  > struct EpiBf16 {
    static constexpr bool PERM = true, AFTER_DRAIN = false; static_assert(ACT == 0 || ACT == 1, "EpiBf16: ACT is 0 (none) or 1 (gelu_pk)");
    bf16_t* O; int ldc; const float* bias; int split_cols; size_t split_stride; float scale0;
    __device__ __forceinline__ void operator()(const f32x4 (&acc)[2][2][4][2], const Unit& u, int wr, int wc, int fr, int fq) const {
        const int row0 = u.pm * BM + wr * 64 + fr; int colt = u.pn * BM; bf16_t* base = O;
        float sc = 1.f; if (split_cols) { const int t = colt / split_cols; base += (size_t)t * split_stride; colt -= t * split_cols; if (t == 0) sc = scale0; }
        const int col0 = colt + wc * 32 + 8 * fq, bcol0 = u.pn * BM + wc * 32 + 8 * fq;
        f32x4 bv[2][2];
#pragma unroll
        for (int bj = 0; bj < 2; ++bj)
#pragma unroll
            for (int n = 0; n < 2; ++n) bv[bj][n] = bias ? *(const f32x4*)(bias + bcol0 + bj * HALF + 4 * n) : (f32x4){0.f, 0.f, 0.f, 0.f};
#pragma unroll
        for (int ai = 0; ai < 2; ++ai)
#pragma unroll
            for (int m = 0; m < 4; ++m) { bf16_t* rowp = base + (size_t)(row0 + ai * HALF + m * 16) * ldc + col0;
#pragma unroll
                for (int bj = 0; bj < 2; ++bj) { f32x4 v0 = acc[ai][bj][m][0] + bv[bj][0], v1 = acc[ai][bj][m][1] + bv[bj][1];
                    if (ACT == 1) { f32x2 a = gelu_pk((f32x2){v0[0], v0[1]}), b = gelu_pk((f32x2){v0[2], v0[3]}), c = gelu_pk((f32x2){v1[0], v1[1]}), d = gelu_pk((f32x2){v1[2], v1[3]});
                        v0 = (f32x4){a.x, a.y, b.x, b.y}; v1 = (f32x4){c.x, c.y, d.x, d.y}; }
                    v0 = v0 * sc; v1 = v1 * sc; u32x4 w; w.x = cvt_pk_bf16(v0[0], v0[1]); w.y = cvt_pk_bf16(v0[2], v0[3]); w.z = cvt_pk_bf16(v1[0], v1[1]); w.w = cvt_pk_bf16(v1[2], v1[3]);
                    *(u32x4*)(rowp + bj * HALF) = w; } }
    }
};

struct EpiQkvRope {
    static constexpr bool PERM = true, AFTER_DRAIN = false;
    bf16_t* Q; size_t kv_stride; const float* qg; const float* kg; const float* rope; float qscale, eps;
    __device__ __forceinline__ void operator()(const f32x4 (&acc)[2][2][4][2], const Unit& u, int wr, int wc, int fr, int fq) const {
        const int row0 = u.pm * BM + wr * 64 + fr;
        if (u.pn == 5) {
            bf16_t* base = Q + 2 * kv_stride; const int col0 = wc * 32 + 8 * fq;
#pragma unroll
            for (int ai = 0; ai < 2; ++ai)
#pragma unroll
                for (int m = 0; m < 4; ++m) { bf16_t* rowp = base + (size_t)(row0 + ai * HALF + m * 16) * 256 + col0;
#pragma unroll
                    for (int bj = 0; bj < 2; ++bj) { const f32x4 v0 = acc[ai][bj][m][0], v1 = acc[ai][bj][m][1];
                        u32x4 w; w.x = cvt_pk_bf16(v0[0], v0[1]); w.y = cvt_pk_bf16(v0[2], v0[3]); w.z = cvt_pk_bf16(v1[0], v1[1]); w.w = cvt_pk_bf16(v1[2], v1[3]);
                        *(u32x4*)(rowp + bj * HALF) = w; } }
            return;
        }
        const bool isq = u.pn < 4;
        bf16_t* base = isq ? Q : Q + kv_stride; const int ldc = isq ? 1024 : 256, hcol = (isq ? u.pn * BM : 0) + wc * 64;
        const float* g = isq ? qg : kg; const float sc = isq ? qscale : 1.f;
        const int dlo = 8 * fq + (fq >= 2 ? 16 : 0), i0 = 8 * (fq & 1);
        const f32x4 g1a = *(const f32x4*)(g + dlo), g1b = *(const f32x4*)(g + dlo + 4), g2a = *(const f32x4*)(g + dlo + 16), g2b = *(const f32x4*)(g + dlo + 20);
#pragma unroll
        for (int ai = 0; ai < 2; ++ai)
#pragma unroll
            for (int m = 0; m < 4; ++m) {
                const int row = row0 + ai * HALF + m * 16, t = row & 8191, pos = fq < 2 ? (t >> 6) : (t & 63);
                const float* tp = rope + (size_t)(pos * 16 + i0) * 2;
                const f32x4 c0 = *(const f32x4*)tp, c1 = *(const f32x4*)(tp + 4), c2 = *(const f32x4*)(tp + 8), c3 = *(const f32x4*)(tp + 12);
                const f32x4 x1a = acc[ai][0][m][0], x1b = acc[ai][0][m][1], x2a = acc[ai][1][m][0], x2b = acc[ai][1][m][1];
                float ss = ((x1a[0] * x1a[0] + x1a[1] * x1a[1]) + (x1a[2] * x1a[2] + x1a[3] * x1a[3])) + ((x1b[0] * x1b[0] + x1b[1] * x1b[1]) + (x1b[2] * x1b[2] + x1b[3] * x1b[3]))
                         + ((x2a[0] * x2a[0] + x2a[1] * x2a[1]) + (x2a[2] * x2a[2] + x2a[3] * x2a[3])) + ((x2b[0] * x2b[0] + x2b[1] * x2b[1]) + (x2b[2] * x2b[2] + x2b[3] * x2b[3]));
                ss += __shfl_xor(ss, 16); ss += __shfl_xor(ss, 32);
                const float rn = sc / sqrtf(ss * (1.0f / 64.0f) + eps);
                const f32x4 y1a = x1a * g1a * rn, y1b = x1b * g1b * rn, y2a = x2a * g2a * rn, y2b = x2b * g2b * rn;
                const f32x4 csa = (f32x4){c0[0], c0[2], c1[0], c1[2]}, sna = (f32x4){c0[1], c0[3], c1[1], c1[3]}, csb = (f32x4){c2[0], c2[2], c3[0], c3[2]}, snb = (f32x4){c2[1], c2[3], c3[1], c3[3]};
                const f32x4 o1a = y1a * csa - y2a * sna, o1b = y1b * csb - y2b * snb, o2a = y2a * csa + y1a * sna, o2b = y2b * csb + y1b * snb;
                bf16_t* rowp = base + (size_t)row * ldc + hcol + dlo;
                u32x4 w1; w1.x = cvt_pk_bf16(o1a[0], o1a[1]); w1.y = cvt_pk_bf16(o1a[2], o1a[3]); w1.z = cvt_pk_bf16(o1b[0], o1b[1]); w1.w = cvt_pk_bf16(o1b[2], o1b[3]);
                u32x4 w2; w2.x = cvt_pk_bf16(o2a[0], o2a[1]); w2.y = cvt_pk_bf16(o2a[2], o2a[3]); w2.z = cvt_pk_bf16(o2b[0], o2b[1]); w2.w = cvt_pk_bf16(o2b[2], o2b[3]);
                *(u32x4*)rowp = w1; *(u32x4*)(rowp + 16) = w2; }
    }
};
__device__ __forceinline__ float silu_mul(float g, float u) { return g * __builtin_amdgcn_rcpf(1.0f + __builtin_amdgcn_exp2f(g * -1.4426950408889634f)) * u; }
struct EpiSwiglu {
    static constexpr bool PERM = true, AFTER_DRAIN = false;
    bf16_t* O; int ldc;
    __device__ __forceinline__ void operator()(const f32x4 (&acc)[2][2][4][2], const Unit& u, int wr, int wc, int fr, int fq) const {
        const int row0 = u.pm * BM + wr * 64 + fr, col0 = u.pn * HALF + wc * 32 + 8 * fq;
#pragma unroll
        for (int ai = 0; ai < 2; ++ai)
#pragma unroll
            for (int m = 0; m < 4; ++m) { bf16_t* rowp = O + (size_t)(row0 + ai * HALF + m * 16) * ldc + col0;
                const f32x4 g0 = acc[ai][0][m][0], g1 = acc[ai][0][m][1], u0 = acc[ai][1][m][0], u1 = acc[ai][1][m][1];
                u32x4 w; w.x = cvt_pk_bf16(silu_mul(g0[0], u0[0]), silu_mul(g0[1], u0[1])); w.y = cvt_pk_bf16(silu_mul(g0[2], u0[2]), silu_mul(g0[3], u0[3]));
                w.z = cvt_pk_bf16(silu_mul(g1[0], u1[0]), silu_mul(g1[1], u1[1])); w.w = cvt_pk_bf16(silu_mul(g1[2], u1[2]), silu_mul(g1[3], u1[3]));
                *(u32x4*)rowp = w; }
    }
};
__device__ __forceinline__ unsigned cvt4_fp8(float a, float b, float c, float d) {
    a = __builtin_fminf(__builtin_fmaxf(a, -448.f), 448.f); b = __builtin_fminf(__builtin_fmaxf(b, -448.f), 448.f); c = __builtin_fminf(__builtin_fmaxf(c, -448.f), 448.f); d = __builtin_fminf(__builtin_fmaxf(d, -448.f), 448.f);
    int w = 0; w = __builtin_amdgcn_cvt_pk_fp8_f32(a, b, w, false); w = __builtin_amdgcn_cvt_pk_fp8_f32(c, d, w, true); return (unsigned)w; }
struct EpiSwigluF8 {
    static constexpr bool PERM = true, AFTER_DRAIN = false;
    unsigned char* O; int ldc; float s;
    __device__ __forceinline__ void operator()(const f32x4 (&acc)[2][2][4][2], const Unit& u, int wr, int wc, int fr, int fq) const {
        const int row0 = u.pm * BM + wr * 64 + fr + 16 * (fq & 1), col0 = u.pn * HALF + wc * 32 + 16 * (fq >> 1);
        const float c1 = -1.4426950408889634f * s, is2 = 1.0f / (s * s);
#define PG8_SILU(G_, U_) (((G_) * (U_)) * __builtin_amdgcn_rcpf(__builtin_fmaf(__builtin_amdgcn_exp2f((G_) * c1), is2, is2)))
#pragma unroll
        for (int ai = 0; ai < 2; ++ai)
#pragma unroll
            for (int mp = 0; mp < 2; ++mp) { unsigned wx[2], wy[2];
#pragma unroll
                for (int q = 0; q < 2; ++q) { const int m = 2 * mp + q; const f32x4 g0 = acc[ai][0][m][0], g1 = acc[ai][0][m][1], u0 = acc[ai][1][m][0], u1 = acc[ai][1][m][1];
                    wx[q] = cvt4_fp8(PG8_SILU(g0[0], u0[0]), PG8_SILU(g0[1], u0[1]), PG8_SILU(g0[2], u0[2]), PG8_SILU(g0[3], u0[3]));
                    wy[q] = cvt4_fp8(PG8_SILU(g1[0], u1[0]), PG8_SILU(g1[1], u1[1]), PG8_SILU(g1[2], u1[2]), PG8_SILU(g1[3], u1[3])); }
                const auto sx = __builtin_amdgcn_permlane16_swap(wx[0], wx[1], false, false), sy = __builtin_amdgcn_permlane16_swap(wy[0], wy[1], false, false);
                u32x4 w; w.x = sx[0]; w.y = sy[0]; w.z = sx[1]; w.w = sy[1];
                *(u32x4*)(O + (size_t)(row0 + ai * HALF + mp * 32) * ldc + col0) = w; }
#undef PG8_SILU
    }
};
struct EpiF8Scale {
    static constexpr bool PERM = true, AFTER_DRAIN = false;
    unsigned char* O; int ldc; float s;
    __device__ __forceinline__ void operator()(const f32x4 (&acc)[2][2][4][2], const Unit& u, int wr, int wc, int fr, int fq) const {
        int fr_ = fr, fq_ = fq; asm volatile("" : "+v"(fr_), "+v"(fq_));
        const int row0 = u.pm * BM + wr * 64 + fr_ + 16 * (fq_ & 1), col0 = u.pn * BM + wc * 32 + 16 * (fq_ >> 1);
#pragma unroll
        for (int ai = 0; ai < 2; ++ai)
#pragma unroll
            for (int mp = 0; mp < 2; ++mp)
#pragma unroll
                for (int bj = 0; bj < 2; ++bj) { unsigned wx[2], wy[2];
#pragma unroll
                    for (int q = 0; q < 2; ++q) { const int m = 2 * mp + q; const f32x4 v0 = acc[ai][bj][m][0] * s, v1 = acc[ai][bj][m][1] * s;
                        wx[q] = cvt4_fp8(v0[0], v0[1], v0[2], v0[3]); wy[q] = cvt4_fp8(v1[0], v1[1], v1[2], v1[3]); }
                    const auto sx = __builtin_amdgcn_permlane16_swap(wx[0], wx[1], false, false), sy = __builtin_amdgcn_permlane16_swap(wy[0], wy[1], false, false);
                    u32x4 w; w.x = sx[0]; w.y = sy[0]; w.z = sx[1]; w.w = sy[1];
                    *(u32x4*)(O + (size_t)(row0 + ai * HALF + mp * 32) * ldc + col0 + bj * HALF) = w; }
    }
};
struct EpiBf16Scale {
    static constexpr bool PERM = true, AFTER_DRAIN = false;
    bf16_t* O; int ldc; float s;
    __device__ __forceinline__ void operator()(const f32x4 (&acc)[2][2][4][2], const Unit& u, int wr, int wc, int fr, int fq) const {
        const int row0 = u.pm * BM + wr * 64 + fr, col0 = u.pn * BM + wc * 32 + 8 * fq;
#pragma unroll
        for (int ai = 0; ai < 2; ++ai)
#pragma unroll
            for (int m = 0; m < 4; ++m) { bf16_t* rowp = O + (size_t)(row0 + ai * HALF + m * 16) * ldc + col0;
#pragma unroll
                for (int bj = 0; bj < 2; ++bj) { const f32x4 v0 = acc[ai][bj][m][0] * s, v1 = acc[ai][bj][m][1] * s;
                    u32x4 w; w.x = cvt_pk_bf16(v0[0], v0[1]); w.y = cvt_pk_bf16(v0[2], v0[3]); w.z = cvt_pk_bf16(v1[0], v1[1]); w.w = cvt_pk_bf16(v1[2], v1[3]);
                    *(u32x4*)(rowp + bj * HALF) = w; } }
    }
};
struct EpiNull {
    static constexpr bool PERM = true, AFTER_DRAIN = false;
    float* sink;
    __device__ __forceinline__ void operator()(const f32x4 (&acc)[2][2][4][2], const Unit& u, int wr, int wc, int fr, int fq) const {
        f32x4 s = acc[0][0][0][0];
#pragma unroll
        for (int ai = 0; ai < 2; ++ai)
#pragma unroll
            for (int bj = 0; bj < 2; ++bj)
#pragma unroll
                for (int m = 0; m < 4; ++m)
#pragma unroll
                    for (int n = 0; n < 2; ++n) s += acc[ai][bj][m][n];
        if (s[0] + s[1] + s[2] + s[3] == 1.2345e-30f) sink[0] = s[0];
    }
};
struct MoeOrder : StaticOrder {
    const volatile PG8_LAS int* ts;
    __device__ __forceinline__ void expert_of(Unit& u) const { int e = 0;
#pragma unroll
        for (int j = 1; j < 8; ++j) e += (u.pm >= ts[j]) ? 1 : 0;
        u.eb = __builtin_amdgcn_readfirstlane(e); }
    __device__ __forceinline__ bool next(int i, Unit& u) const { if (!StaticOrder::next(i, u)) return false; expert_of(u); return true; }
    __device__ __forceinline__ void at(int L, Unit& u) const { StaticOrder::at(L, u); expert_of(u); }
};
struct SplitKOrder : MoeOrder { int pm0, KS, kpart, ntot;
    __device__ __forceinline__ bool next(int i, Unit& u) const { const int L = i * G + c; if (L >= ntot) return false; const int ui = L / KS; u.pm = pm0 + ui / nN; u.pn = ui % nN; expert_of(u); u.kb = (L % KS) * kpart; u.po = L; return true; }
};
struct EpiBf16Part {
    static constexpr bool PERM = true, AFTER_DRAIN = false;
    bf16_t* O; float s;
    __device__ __forceinline__ void operator()(const f32x4 (&acc)[2][2][4][2], const Unit& u, int wr, int wc, int fr, int fq) const {
        int fr_ = fr, fq_ = fq; asm volatile("" : "+v"(fr_), "+v"(fq_));
        const int row0 = wr * 64 + fr_, col0 = wc * 32 + 8 * fq_; bf16_t* const T = O + (size_t)u.po * (BM * BM);
#pragma unroll
        for (int ai = 0; ai < 2; ++ai)
#pragma unroll
            for (int m = 0; m < 4; ++m) { bf16_t* rowp = T + (size_t)(row0 + ai * HALF + m * 16) * BM + col0;
#pragma unroll
                for (int bj = 0; bj < 2; ++bj) { const f32x4 v0 = acc[ai][bj][m][0] * s, v1 = acc[ai][bj][m][1] * s;
                    u32x4 w; w.x = cvt_pk_bf16(v0[0], v0[1]); w.y = cvt_pk_bf16(v0[2], v0[3]); w.z = cvt_pk_bf16(v1[0], v1[1]); w.w = cvt_pk_bf16(v1[2], v1[3]);
                    *(u32x4*)(rowp + bj * HALF) = w; } }
    }
};
struct OneUnit { Unit u{};
    __device__ __forceinline__ bool next(int i, Unit& o) const { if (i != 0) return false; o = u; return true; }
    __device__ __forceinline__ void a_ready(const Unit&) const {}
    __device__ __forceinline__ void done(const Unit&) const {}
};
template <class Epi, class Sched, bool ALIGN_EPI = false, bool SP2 = false, bool F8 = false>
__device__ __forceinline__ void gemm_phase(PG8_LAS unsigned char* lds, const Gemm g, const Sched& S, const Epi& E) {
    int tid_ = threadIdx.x; asm volatile("" : "+v"(tid_));
    const int tid = tid_, wid = __builtin_amdgcn_readfirstlane(tid >> 6), lane = tid & 63, wr = wid >> 2, wc = wid & 3, fr = lane & 15, fq = lane >> 4;
    const int K = g.K, nt = g.ntk ? g.ntk : K / BK;
    unsigned voffA[2], voffB[2];
#pragma unroll
    for (int i = 0; i < 2; ++i) { int R, C; stage_rc(tid * 16 + i * 8192, R, C); const int Rb = Epi::PERM ? ((R & ~31) + perm32(R & 31)) : R;
        voffA[i] = (unsigned)(R * K + C) * 2u; voffB[i] = (unsigned)(Rb * K + C) * 2u; }
    const size_t kstep = (size_t)(BK * 2);
    const size_t hstep = (size_t)HALF * K * 2;
    const size_t tstep = 2 * hstep;
    const unsigned ldsw = (unsigned)wid * 1024u;
    const int aoff = lds_byte(wr * 64 + fr, fq * 8), boff = lds_byte(wc * 32 + fr, fq * 8);
#define PG8_SA(b, h) (((b) * 2 + (h)) * HTB)
#define PG8_SB(b, h) ((4 + (b) * 2 + (h)) * HTB)
#define PG8_STAGE(bufoff, gbase, voff) do { _Pragma("unroll") for (int _i = 0; _i < 2; ++_i) \
        __builtin_amdgcn_global_load_lds((const unsigned*)((const char*)(gbase) + (voff)[_i]), (PG8_LAS unsigned*)(lds + (bufoff) + ldsw + _i * 8192), 16, 0, 0); } while (0)
#define PG8_RD16(off) (*(const PG8_LAS i32x4*)(lds + (off)))
#define PG8_CAT(x, y) __builtin_shufflevector((x), (y), 0, 1, 2, 3, 4, 5, 6, 7)
#define PG8_LDA(dst, b, h) do { _Pragma("unroll") for (int m = 0; m < 4; ++m) { if constexpr (F8) dst##8[m] = PG8_CAT(PG8_RD16(PG8_SA(b, h) + aoff + m * 2048), PG8_RD16(PG8_SA(b, h) + aoff + m * 2048 + 1024)); \
        else { _Pragma("unroll") for (int k = 0; k < 2; ++k) dst[m][k] = *(const PG8_LAS bf16x8*)(lds + PG8_SA(b, h) + aoff + m * 2048 + k * 1024); } } } while (0)
#define PG8_LDB(dst, b, h) do { _Pragma("unroll") for (int n = 0; n < 2; ++n) { if constexpr (F8) dst##8[n] = PG8_CAT(PG8_RD16(PG8_SB(b, h) + boff + n * 2048), PG8_RD16(PG8_SB(b, h) + boff + n * 2048 + 1024)); \
        else { _Pragma("unroll") for (int k = 0; k < 2; ++k) dst[n][k] = *(const PG8_LAS bf16x8*)(lds + PG8_SB(b, h) + boff + n * 2048 + k * 1024); } } } while (0)
#define PG8_MMA(ai, bj, At, Bt) do { __builtin_amdgcn_s_setprio(1); _Pragma("unroll") for (int m = 0; m < 4; ++m) _Pragma("unroll") for (int n = 0; n < 2; ++n) { \
        if constexpr (F8) asm volatile("v_mfma_f32_16x16x128_f8f6f4 %0, %1, %2, %0" : "+v"(acc[ai][bj][m][n]) : "v"(Bt##8[n]), "v"(At##8[m]));   \
        else { _Pragma("unroll") for (int k = 0; k < 2; ++k) acc[ai][bj][m][n] = __builtin_amdgcn_mfma_f32_16x16x32_bf16(Bt[n][k], At[m][k], acc[ai][bj][m][n], 0, 0, 0); } } \
        __builtin_amdgcn_s_setprio(0); } while (0)
#define PG8_WAIT_V(n) asm volatile("s_waitcnt vmcnt(" #n ")" ::: "memory")
#define PG8_WAIT_L(n) asm volatile("s_waitcnt lgkmcnt(" #n ")" ::: "memory")
#define PG8_BAR __builtin_amdgcn_s_barrier()
#define PG8_SCHED __builtin_amdgcn_sched_barrier(0)
    Unit cur, nxt; int ui = 0;
    if (!S.next(0, cur)) return;
    f32x4 acc[2][2][4][2];
#pragma unroll
    for (int a = 0; a < 2; ++a)
#pragma unroll
        for (int b = 0; b < 2; ++b)
#pragma unroll
            for (int m = 0; m < 4; ++m)
#pragma unroll
                for (int n = 0; n < 2; ++n) { f32x4 z_ = (f32x4){0.f, 0.f, 0.f, 0.f}; asm volatile("" : "+v"(z_)); acc[a][b][m][n] = z_; }
    bf16x8 At[4][2], B0[2][2], B1[2][2]; i32x8 At8[4], B08[2], B18[2];
    const char* cA = (const char*)g.A + (size_t)cur.pm * tstep + cur.kb; const char* cB = (const char*)g.Bt + (size_t)cur.eb * g.bstride + (size_t)cur.pn * tstep + cur.kb;
    S.a_ready(cur);
    if constexpr (SP2) {
        PG8_STAGE(PG8_SB(0, 0), cB, voffB); PG8_STAGE(PG8_SB(0, 1), cB + hstep, voffB); PG8_STAGE(PG8_SA(0, 0), cA, voffA); PG8_STAGE(PG8_SA(0, 1), cA + hstep, voffA);
        if (wr == 1) PG8_BAR;
        PG8_WAIT_V(2); PG8_BAR;
        PG8_STAGE(PG8_SB(1, 0), cB + kstep, voffB); PG8_STAGE(PG8_SA(1, 0), cA + kstep, voffA); PG8_STAGE(PG8_SB(1, 1), cB + hstep + kstep, voffB);
        PG8_WAIT_V(6); PG8_BAR;
    } else {
        PG8_STAGE(PG8_SB(0, 0), cB, voffB); PG8_STAGE(PG8_SA(0, 0), cA, voffA); PG8_STAGE(PG8_SB(0, 1), cB + hstep, voffB); PG8_STAGE(PG8_SA(0, 1), cA + hstep, voffA);
        if (wr == 1) PG8_BAR;
        PG8_WAIT_V(4); PG8_BAR;
        PG8_STAGE(PG8_SB(1, 0), cB + kstep, voffB); PG8_STAGE(PG8_SA(1, 0), cA + kstep, voffA); PG8_STAGE(PG8_SB(1, 1), cB + hstep + kstep, voffB);
        PG8_WAIT_V(6); PG8_BAR;
    }
    for (;;) {
        const bool has_next = S.next(ui + 1, nxt);
        const char* nA = has_next ? (const char*)g.A + (size_t)nxt.pm * tstep + nxt.kb : cA; const char* nB = has_next ? (const char*)g.Bt + (size_t)nxt.eb * g.bstride + (size_t)nxt.pn * tstep + nxt.kb : cB;
        asm volatile(".p2align 6");
        _Pragma("nounroll") for (int t = 0; t < nt; t += 2) {
            const bool last = (t == nt - 2);
            const char* a1 = cA + (size_t)(t + 1) * kstep;
            const char* a2 = last ? nA : cA + (size_t)(t + 2) * kstep; const char* b2 = last ? nB : cB + (size_t)(t + 2) * kstep;
            const char* a3 = a2 + kstep; const char* b3 = b2 + kstep;
            if (last && has_next) S.a_ready(nxt);
            if constexpr (SP2) {
            PG8_LDB(B0, 0, 0); PG8_LDB(B1, 0, 1); PG8_SCHED; PG8_LDA(At, 0, 0); PG8_STAGE(PG8_SA(1, 1), a1 + hstep, voffA);
            PG8_WAIT_V(8); PG8_WAIT_L(0); PG8_BAR; PG8_MMA(0, 0, At, B0); PG8_MMA(0, 1, At, B1); PG8_BAR; PG8_SCHED;
            PG8_LDA(At, 0, 1); PG8_STAGE(PG8_SB(0, 0), b2, voffB); PG8_STAGE(PG8_SB(0, 1), b2 + hstep, voffB); PG8_STAGE(PG8_SA(0, 0), a2, voffA);
            PG8_WAIT_V(8); PG8_WAIT_L(0); PG8_BAR; PG8_MMA(1, 0, At, B0); PG8_MMA(1, 1, At, B1); PG8_BAR; PG8_SCHED;
            PG8_LDB(B0, 1, 0); PG8_LDB(B1, 1, 1); PG8_SCHED; PG8_LDA(At, 1, 0); PG8_STAGE(PG8_SA(0, 1), a2 + hstep, voffA);
            PG8_WAIT_V(8); PG8_WAIT_L(0); PG8_BAR; PG8_MMA(0, 0, At, B0); PG8_MMA(0, 1, At, B1); PG8_BAR; PG8_SCHED;
            PG8_LDA(At, 1, 1); PG8_STAGE(PG8_SB(1, 0), b3, voffB); PG8_STAGE(PG8_SB(1, 1), b3 + hstep, voffB); PG8_STAGE(PG8_SA(1, 0), a3, voffA);
            PG8_WAIT_V(8); PG8_WAIT_L(0); PG8_BAR; PG8_MMA(1, 0, At, B0); PG8_MMA(1, 1, At, B1); PG8_BAR; PG8_SCHED;
            } else {
            PG8_LDB(B0, 0, 0); PG8_SCHED; PG8_LDA(At, 0, 0); PG8_STAGE(PG8_SA(1, 1), a1 + hstep, voffA);
            PG8_WAIT_L(8); PG8_BAR; PG8_WAIT_L(0); PG8_MMA(0, 0, At, B0); PG8_BAR; PG8_SCHED;
            PG8_LDB(B1, 0, 1); PG8_STAGE(PG8_SB(0, 0), b2, voffB);
            PG8_BAR; PG8_WAIT_L(0); PG8_MMA(0, 1, At, B1); PG8_BAR;
            PG8_LDA(At, 0, 1); PG8_STAGE(PG8_SA(0, 0), a2, voffA);
            PG8_BAR; PG8_WAIT_L(0); PG8_MMA(1, 0, At, B0); PG8_BAR; PG8_SCHED;
            PG8_STAGE(PG8_SB(0, 1), b2 + hstep, voffB);
            PG8_WAIT_V(6); PG8_BAR; PG8_MMA(1, 1, At, B1); PG8_BAR;
            PG8_LDB(B0, 1, 0); PG8_SCHED; PG8_LDA(At, 1, 0); PG8_STAGE(PG8_SA(0, 1), a2 + hstep, voffA);
            PG8_WAIT_L(8); PG8_BAR; PG8_WAIT_L(0); PG8_MMA(0, 0, At, B0); PG8_BAR; PG8_SCHED;
            PG8_LDB(B1, 1, 1); PG8_STAGE(PG8_SB(1, 0), b3, voffB);
            PG8_BAR; PG8_WAIT_L(0); PG8_MMA(0, 1, At, B1); PG8_BAR;
            PG8_LDA(At, 1, 1); PG8_STAGE(PG8_SA(1, 0), a3, voffA);
            PG8_BAR; PG8_WAIT_L(0); PG8_MMA(1, 0, At, B0); PG8_BAR; PG8_SCHED;
            PG8_STAGE(PG8_SB(1, 1), b3 + hstep, voffB);
            PG8_WAIT_V(6); PG8_BAR; PG8_MMA(1, 1, At, B1); PG8_BAR;
            }
        }
        if constexpr (ALIGN_EPI) { if (wr == 0) PG8_BAR; }
        if constexpr (F8) asm volatile("s_nop 15\n\ts_nop 15" ::: "memory");
        if constexpr (!Epi::AFTER_DRAIN) { E(acc, cur, wr, wc, fr, fq); S.done(cur); }
        if (!has_next) break;
#pragma unroll
        for (int a = 0; a < 2; ++a)
#pragma unroll
            for (int b = 0; b < 2; ++b)
#pragma unroll
                for (int m = 0; m < 4; ++m)
#pragma unroll
                    for (int n = 0; n < 2; ++n) { f32x4 z_ = (f32x4){0.f, 0.f, 0.f, 0.f}; asm volatile("" : "+v"(z_)); acc[a][b][m][n] = z_; }
        cur = nxt; cA = nA; cB = nB; ++ui;
        if constexpr (ALIGN_EPI) { if (wr == 1) PG8_BAR; }
    }
    PG8_WAIT_V(0);
    if constexpr (!ALIGN_EPI) { if (wr == 0) PG8_BAR; }
    PG8_BAR;
    if constexpr (Epi::AFTER_DRAIN) { E.fused(acc, cur, wr, wc, fr, fq, lds, wid, lane); S.done(cur); }
#undef PG8_SA
#undef PG8_SB
#undef PG8_STAGE
#undef PG8_LDA
#undef PG8_LDB
#undef PG8_MMA
#undef PG8_CAT
#undef PG8_RD16
#undef PG8_WAIT_V
#undef PG8_WAIT_L
#undef PG8_BAR
#undef PG8_SCHED
}
}

#ifndef PG8_SP2
#define PG8_SP2 true
#endif
#ifndef PG8_ALIGN
#define PG8_ALIGN true
#endif
#include <hip/hip_bf16.h>
#include <cmath>
namespace attn_body {
using bf16=__hip_bfloat16;
using bf16x8=__attribute__((ext_vector_type(8)))short;
using s16x4=__attribute__((ext_vector_type(4)))short;
using f32x16=__attribute__((ext_vector_type(16)))float;
using u32x4=__attribute__((ext_vector_type(4)))unsigned;
constexpr int BATCH=2,NHEAD=16,SEQ=8192,D=64;
constexpr int NW=8,QBLK=32,QB=QBLK*NW,KVBLK=64,NQB=SEQ/QB;
constexpr int ATTN_UNIT_ROWS=QB;
__device__ __forceinline__ int crow(int r,int hi){return (r&3)+8*(r>>2)+4*hi;}
#define SBAR() __builtin_amdgcn_sched_barrier(0)
typedef __attribute__((address_space(3))) const float* lds_fptr;
typedef float f32x4n __attribute__((ext_vector_type(4)));
constexpr float NA_NEG=-1000.f; constexpr int NA_TROW=132, NA_TCOPY=15*NA_TROW;
constexpr unsigned long long na_lanemask(int par,int P,int r){ unsigned long long m=0;
  for(int lane=0;lane<64;++lane){ const int r32=lane&31,hi=lane>>5,c=32*par+r32; int cs=c-8; cs=cs<0?0:(cs>48?48:cs); const int kc=(r&3)+8*(r>>2)+4*hi+32*P; if(kc-cs>=0&&kc-cs<16)m|=1ull<<lane; }
  return m; }
template<int PAR,int P,int R> struct NaM { static constexpr unsigned long long v=na_lanemask(PAR,P,R); };
template<int PAR,int P,int G> struct NaG { static constexpr bool any=(NaM<PAR,P,4*G>::v|NaM<PAR,P,4*G+1>::v|NaM<PAR,P,4*G+2>::v|NaM<PAR,P,4*G+3>::v)!=0ull; };
template<int PAR,int P,int R> __device__ __forceinline__ float na_el(float x,float b){
  constexpr unsigned long long m=NaM<PAR,P,R>::v;
  if constexpr(m==0ull){ return NA_NEG; }
  else{ float y=x+b; if constexpr(m!=~0ull){ asm("v_cndmask_b32 %0, %1, %0, %2":"+v"(y):"v"(NA_NEG),"s"(m)); } return y; }
}
template<int PAR,int P,int G> __device__ __forceinline__ void na_grp(f32x16&p,lds_fptr tr,float mh){
  if constexpr(NaG<PAR,P,G>::any){ const f32x4n b=*(const __attribute__((address_space(3))) f32x4n*)(tr+32*P+8*G)-mh;
    p[4*G]=na_el<PAR,P,4*G>(p[4*G],b[0]); p[4*G+1]=na_el<PAR,P,4*G+1>(p[4*G+1],b[1]); p[4*G+2]=na_el<PAR,P,4*G+2>(p[4*G+2],b[2]); p[4*G+3]=na_el<PAR,P,4*G+3>(p[4*G+3],b[3]); }
  else{ p[4*G]=NA_NEG;p[4*G+1]=NA_NEG;p[4*G+2]=NA_NEG;p[4*G+3]=NA_NEG; }
}
template<int PAR> __device__ __forceinline__ void namask(f32x16&p0,f32x16&p1,int t,int rowlo,int robase,lds_fptr tr0,float mh){
  if((unsigned)(t-rowlo)>=8u){
    #pragma unroll
    for(int r=0;r<16;++r){p0[r]=NA_NEG;p1[r]=NA_NEG;}
  }else{
    lds_fptr tr=tr0+(robase+t)*NA_TROW;
    na_grp<PAR,0,0>(p0,tr,mh);na_grp<PAR,0,1>(p0,tr,mh);na_grp<PAR,0,2>(p0,tr,mh);na_grp<PAR,0,3>(p0,tr,mh);
    na_grp<PAR,1,0>(p1,tr,mh);na_grp<PAR,1,1>(p1,tr,mh);na_grp<PAR,1,2>(p1,tr,mh);na_grp<PAR,1,3>(p1,tr,mh);
  }
}
constexpr int NSLOT=3, SLOTB=8192;
constexpr int LDS_K=0, LDS_V=NSLOT*SLOTB, LDS_WS=2*NSLOT*SLOTB, LDS_OST=LDS_WS+NW*64*4, LDS_BYTES=LDS_OST+NW*4096;
constexpr float C2=0.125f*1.4426950408889634f;
__device__ __forceinline__ void glds16(const void*gsrc,unsigned lds_dst){unsigned keep;
  asm volatile("s_mov_b32 %0, m0\n\ts_mov_b32 m0, %2\n\ts_nop 0\n\tglobal_load_lds_dwordx4 %1, off\n\ts_mov_b32 m0, %0":"=&s"(keep):"v"(gsrc),"s"(lds_dst):"memory");}
__device__ __forceinline__ float max3f(float a,float b,float c){float r;asm("v_max3_f32 %0, %1, %2, %3":"=v"(r):"v"(a),"v"(b),"v"(c));return r;}
__device__ __forceinline__ float max2f(float a,float b){float r;asm("v_max_f32_e32 %0, %1, %2":"=v"(r):"v"(a),"v"(b));return r;}
__device__ __forceinline__ float fadd_s(float a,float b){float r;asm("v_add_f32_e32 %0, %1, %2":"=v"(r):"v"(a),"v"(b));return r;}
__device__ __forceinline__ float fsub_s(float a,float b){float r;asm("v_sub_f32_e32 %0, %1, %2":"=v"(r):"v"(a),"v"(b));return r;}
typedef float f32x2_t __attribute__((ext_vector_type(2))); typedef __bf16 bf16x2_t __attribute__((ext_vector_type(2)));
__device__ __forceinline__ unsigned cvtpk_s(float lo,float hi){f32x2_t v={lo,hi};bf16x2_t b=__builtin_convertvector(v,bf16x2_t);return __builtin_bit_cast(unsigned,b);}
#define WAIT_BAR(N) asm volatile("s_waitcnt vmcnt(" #N ") lgkmcnt(0)\n\ts_barrier":::"memory")

__device__ __forceinline__ void qkt(f32x16&p0,f32x16&p1,const char*Kslot,const bf16x8*qr,const f32x16&negm,int r32,int hi){
  const char*kb=Kslot+hi*1024+r32*16;
  #pragma unroll
  for(int d0=0;d0<4;++d0){
    const bf16x8 b0=*reinterpret_cast<const bf16x8*>(kb+d0*2048);
    const bf16x8 b1=*reinterpret_cast<const bf16x8*>(kb+d0*2048+512);
    if(d0==0){p0=__builtin_amdgcn_mfma_f32_32x32x16_bf16(b0,qr[0],negm,0,0,0);p1=__builtin_amdgcn_mfma_f32_32x32x16_bf16(b1,qr[0],negm,0,0,0);}
    else{p0=__builtin_amdgcn_mfma_f32_32x32x16_bf16(b0,qr[d0],p0,0,0,0);p1=__builtin_amdgcn_mfma_f32_32x32x16_bf16(b1,qr[d0],p1,0,0,0);}}
}
typedef __attribute__((address_space(3))) const char* lds_cptr;
typedef short v4i16_t __attribute__((ext_vector_type(4)));
__device__ __forceinline__ void kload8(bf16x8*kf,lds_cptr kp){
  kf[0]=*(const __attribute__((address_space(3))) bf16x8*)(kp);      kf[1]=*(const __attribute__((address_space(3))) bf16x8*)(kp+512);
  kf[2]=*(const __attribute__((address_space(3))) bf16x8*)(kp+2048); kf[3]=*(const __attribute__((address_space(3))) bf16x8*)(kp+2560);
  kf[4]=*(const __attribute__((address_space(3))) bf16x8*)(kp+4096); kf[5]=*(const __attribute__((address_space(3))) bf16x8*)(kp+4608);
  kf[6]=*(const __attribute__((address_space(3))) bf16x8*)(kp+6144); kf[7]=*(const __attribute__((address_space(3))) bf16x8*)(kp+6656);
}
__device__ __forceinline__ void kload2(bf16x8*kf,lds_cptr kp,int j){ kf[2*j]=*(const __attribute__((address_space(3))) bf16x8*)(kp+j*2048); kf[2*j+1]=*(const __attribute__((address_space(3))) bf16x8*)(kp+j*2048+512); }
__device__ __forceinline__ s16x4 vtr(lds_cptr p){ return __builtin_bit_cast(s16x4,__builtin_amdgcn_ds_read_tr16_b64_v4i16((__attribute__((address_space(3))) v4i16_t*)p)); }
__device__ __forceinline__ float rowmax(const f32x16&p0,const f32x16&p1){
  float a=max3f(p0[0],p0[1],p1[0]),b=max3f(p0[2],p0[3],p1[1]);a=max3f(a,p1[2],p1[3]);
  #pragma unroll
  for(int r=4;r<16;r+=4){a=max3f(a,p0[r],p0[r+1]);b=max3f(b,p0[r+2],p0[r+3]);a=max3f(a,p1[r],p1[r+1]);b=max3f(b,p1[r+2],p1[r+3]);}
  const float m=max2f(a,b);
  auto rr=__builtin_amdgcn_permlane32_swap(__float_as_uint(m),__float_as_uint(m),false,false);
  return max2f(__uint_as_float(rr[0]),__uint_as_float(rr[1]));
}
__device__ __forceinline__ void pv(f32x16*o,int vb,bf16x8 pa0,bf16x8 pa1,bf16x8 pa2,bf16x8 pa3){
  #pragma unroll
  for(int d0=0;d0<2;++d0){s16x4 lo[4],hi[4];
    #pragma unroll
    for(int ks=0;ks<4;++ks){
      asm volatile("ds_read_b64_tr_b16 %0,%1 offset:%c2":"=&v"(lo[ks]):"v"(vb),"i"(d0*4096+ks*1024):"memory");
      asm volatile("ds_read_b64_tr_b16 %0,%1 offset:%c2":"=&v"(hi[ks]):"v"(vb),"i"(d0*4096+ks*1024+512):"memory");}
    asm volatile("s_waitcnt lgkmcnt(0)":::"memory");SBAR();
    #define PK(k) (bf16x8){lo[k][0],lo[k][1],lo[k][2],lo[k][3],hi[k][0],hi[k][1],hi[k][2],hi[k][3]}
    o[d0]=__builtin_amdgcn_mfma_f32_32x32x16_bf16(pa0,PK(0),o[d0],0,0,0);
    o[d0]=__builtin_amdgcn_mfma_f32_32x32x16_bf16(pa1,PK(1),o[d0],0,0,0);
    o[d0]=__builtin_amdgcn_mfma_f32_32x32x16_bf16(pa2,PK(2),o[d0],0,0,0);
    o[d0]=__builtin_amdgcn_mfma_f32_32x32x16_bf16(pa3,PK(3),o[d0],0,0,0);
    #undef PK
  }
}

struct SideJob { const float* mg; const float* mu; unsigned char* wt; int p0, cnt; unsigned lds; float scale; };
constexpr int SJ_K=1024, SJ_N=3584, SJ_NB=SJ_N/32, SJ_PK=8, SJ_MODE=0, SJ_KP=SJ_K/SJ_PK, SJ_SLOT=SJ_PK*32*4, SJ_STAGE=4*SJ_SLOT;
__device__ __forceinline__ void glds16s(const void*sbase,unsigned voff,unsigned lds_dst){unsigned keep;
  asm volatile("s_mov_b32 %0, m0\n\ts_mov_b32 m0, %3\n\ts_nop 3\n\tglobal_load_lds_dwordx4 %1, %2\n\ts_mov_b32 m0, %0":"=&s"(keep):"v"(voff),"s"(sbase),"s"(lds_dst):"memory");}
__device__ __forceinline__ void glds16u(const void*sbase,unsigned voff,unsigned lds_dst){unsigned keep;
  asm volatile("s_mov_b32 %0, m0\n\ts_mov_b32 m0, %3\n\ts_nop 0\n\tglobal_load_lds_dwordx4 %1, %2\n\ts_mov_b32 m0, %0":"=&s"(keep):"v"(voff),"s"(sbase),"s"(lds_dst):"memory");}
#ifndef ATTN_STORE16
#define ATTN_STORE16(p,v) (*(u32x4*)(p)=(v))
#endif
template<int MODE,int PQ,int PK,int THRL,bool NOMAX,bool ODD=false,bool SIDE=false> __device__ __forceinline__ void attn_unit(int b,int hq,int hk,int q0,int k0,int NT,const bf16*Q,const bf16*__restrict__ K,const bf16*__restrict__ V,bf16*O,char*shm,int na_r0,int na_first,lds_fptr na_tab,const SideJob sj=SideJob{}){
  int tid_=threadIdx.x; asm volatile("":"+v"(tid_)); const int tid=tid_,lane=tid&63,r32=lane&31,hi=lane>>5; const int wid=__builtin_amdgcn_readfirstlane(tid>>6);
  const long rowbase=(long)b*SEQ;
  const bf16*Qw=Q+(rowbase+q0+wid*QBLK)*PQ+hq*D;
  const bf16*Kh=K+(rowbase+k0)*PK+hk*D,*Vh=V+(rowbase+k0)*PK+hk*D;
  const unsigned lds0=(unsigned)(uintptr_t)shm;
  float*wsf=(float*)(shm+LDS_WS)+wid*64;
  const unsigned kvo=(unsigned)((lane*PK+wid*8)*2);
  const unsigned vvo=(unsigned)(((16*(wid&3)+(lane>>2))*PK+(wid>>2)*32+(lane&3)*8)*2);
  const unsigned kdst=lds0+LDS_K+wid*1024, vdst=lds0+LDS_V+wid*1024;
  #define DMA_K(t,slot) glds16u(Kh+(long)(t)*KVBLK*PK,kvo,(unsigned)__builtin_amdgcn_readfirstlane(kdst+(slot)))
  #define DMA_V(t,slot) glds16u(Vh+(long)(t)*KVBLK*PK,vvo,(unsigned)__builtin_amdgcn_readfirstlane(vdst+(slot)))
  const int vb0=(int)(lds0+LDS_V)+((lane>>4)&1)*32+(lane&3)*8+(4*hi+((lane&15)>>2))*64;
  const char*Kbase=shm+LDS_K; bf16x8 kf[8];
  const lds_cptr shm3=(lds_cptr)shm; const lds_cptr kp0=shm3+LDS_K+hi*1024+r32*16; const lds_cptr vp0=shm3+LDS_V+((lane>>4)&1)*32+(lane&3)*8+(4*hi+((lane&15)>>2))*64;
  DMA_K(0,0);DMA_V(0,0);DMA_K(1,SLOTB);
  bf16x8 qr[4];
  #pragma unroll
  for(int d0=0;d0<4;++d0)qr[d0]=*reinterpret_cast<const bf16x8*>(&Qw[(long)r32*PQ+d0*16+hi*8]);
  float mhat=0.f,l_reg=0.f;f32x16 o[2];o[0]=f32x16{};o[1]=f32x16{};f32x16 negm=f32x16{}; if constexpr(!NOMAX&&MODE!=1) asm volatile("":"+v"(negm));
  int na_rowlo=0,na_robase=0; lds_fptr na_tr0=na_tab;
  if constexpr(MODE==1){ const int r_=na_r0+(wid>>1), c_=32*(wid&1)+r32; int rs_=r_-4; rs_=rs_<0?0:(rs_>SEQ/64-8?SEQ/64-8:rs_);
    na_rowlo=__builtin_amdgcn_readfirstlane(rs_-na_first); na_robase=__builtin_amdgcn_readfirstlane(na_first-r_+7); na_tr0=na_tab+(c_&3)*NA_TCOPY+(64-(c_-(c_&3))+4*hi); }
  #define CMASK(P0,P1,t) do{ if constexpr(MODE==1){ if(wid&1) namask<1>(P0,P1,(t),na_rowlo,na_robase,na_tr0,mhat); else namask<0>(P0,P1,(t),na_rowlo,na_robase,na_tr0,mhat); } }while(0)
  bool resc=false;
  #define START(P0,P1) do{ if constexpr(!NOMAX){ const float rm=rowmax(P0,P1); resc=false; \
    { const float dl=rm; mhat=fadd_s(mhat,dl); \
      _Pragma("unroll") for(int r=0;r<16;++r){P0[r]=fsub_s(P0[r],dl);P1[r]=fsub_s(P1[r],dl);} \
      if constexpr(MODE!=1){ _Pragma("unroll") for(int r=0;r<16;++r)negm[r]=-mhat; asm volatile("":"+v"(negm)); } } } \
    _Pragma("unroll") for(int r=0;r<16;++r)P0[r]=__builtin_amdgcn_exp2f(P0[r]); }while(0)
  #define RESC() do{ if constexpr(!NOMAX) if(resc){ asm volatile("s_waitcnt lgkmcnt(0)":::"memory"); \
      _Pragma("unroll") for(int d_=0;d_<2;++d_) _Pragma("unroll") for(int r=0;r<16;++r)o[d_][r]*=wsf[crow(r,hi)]; } }while(0)
  f32x16 pA0,pA1,pB0,pB1;
  typedef short sj_v2s __attribute__((ext_vector_type(2))); const float sj_iscale=1.0f/sj.scale;
  int sj_c=0; float sa0=0.f,sa1=0.f,sa2=0.f,sa3=0.f;
  const int sj_p0=sj.p0+wid*sj.cnt; const unsigned sj_lds=(unsigned)__builtin_amdgcn_readfirstlane((int)(sj.lds+wid*SJ_STAGE));
  const unsigned sj_vld=(unsigned)(((lane>>3)*SJ_N+4*(lane&7))*4), sj_vst=(unsigned)((lane>>3)*SJ_K+16*(lane&7));
  const unsigned sj_bw=(unsigned)(lds0+LDS_OST+wid*4096+(lane&31)*128+4*(lane>>5)), sj_bx=(unsigned)((lane&7)<<4);
  const unsigned sj_br=(unsigned)(lds0+LDS_OST+wid*4096+(lane>>3)*128+(((lane&7)^((lane>>3)&7))<<4));
  const __attribute__((address_space(3))) float*sj_rd=(const __attribute__((address_space(3))) float*)(uintptr_t)(sj.lds+wid*SJ_STAGE+(lane>>5)*512+(lane&31)*4);
  #define SIDE_RD() do{ const __attribute__((address_space(3))) float*rp_=sj_rd+(((sj_c+1)&3)<<8); sa0=rp_[0];sa1=rp_[32];sa2=rp_[64];sa3=rp_[96]; }while(0)
  #define SIDE_ST(c_) (SJ_MODE==0&&(c_)>=18&&(c_)-3<sj.cnt&&(((c_)-3)&15)==15)
  const float*sj_srcA=sj.mg,*sj_srcB=sj.mg; unsigned char*sj_dstA=sj.wt,*sj_dstB=sj.wt; int sj_w=0;
  if constexpr(SIDE){
    #define SJ_DEC(p_,SRC,DST) do{ const int kp_=(p_)%SJ_KP, q_=(p_)/SJ_KP, eu_=q_/SJ_NB, nb_=q_-eu_*SJ_NB, e_=eu_>>1, up_=eu_&1; \
      SRC=(up_?sj.mu:sj.mg)+((size_t)(e_*SJ_K+SJ_PK*kp_)*SJ_N+32*nb_); DST=sj.wt+(size_t)e_*(2*SJ_N*SJ_K)+(size_t)(256*(nb_>>2)+32*(nb_&3)+128*up_)*SJ_K+SJ_PK*kp_; }while(0)
    sj_w=SJ_KP-(sj_p0%SJ_KP); SJ_DEC(sj_p0,sj_srcA,sj_dstA); SJ_DEC(sj_p0+sj_w,sj_srcB,sj_dstB);
    #undef SJ_DEC
  }
  #define SIDE_LD() do{ const int cm_=sj.cnt-1; const int il_=sj_c>cm_?cm_:sj_c; const float*sp_=il_<sj_w?sj_srcA+(size_t)il_*(SJ_PK*SJ_N):sj_srcB+(size_t)(il_-sj_w)*(SJ_PK*SJ_N); glds16s(sp_,sj_vld,sj_lds+((sj_c&3)<<10)); }while(0)
  #define SIDE_CV() do{ \
    { sj_v2s lo_={0,0}; lo_=__builtin_amdgcn_cvt_scalef32_pk_fp8_f32(lo_,sa0,sa1,sj_iscale,false); lo_=__builtin_amdgcn_cvt_scalef32_pk_fp8_f32(lo_,sa2,sa3,sj_iscale,true);     \
      const int q_=sj_c-3; if(q_>=0&&q_<sj.cnt){ const unsigned qq_=(unsigned)q_&15u;       \
        *(__attribute__((address_space(3))) unsigned*)(uintptr_t)(sj_bw+((((qq_>>1)<<4))^sj_bx)+((qq_&1u)<<3))=__builtin_bit_cast(unsigned,lo_); } } \
    if(SIDE_ST(sj_c)){ const int ib_=sj_c-18; unsigned char*dp_=(ib_<sj_w?sj_dstA+SJ_PK*ib_:sj_dstB+SJ_PK*(ib_-sj_w))+sj_vst;     \
      _Pragma("unroll") for(int j_=0;j_<4;++j_){ const u32x4 w_=*(const __attribute__((address_space(3))) u32x4*)(uintptr_t)(sj_br+j_*1024); *(u32x4*)(dp_+(size_t)j_*8*SJ_K)=w_; SBAR(); } } \
    ++sj_c; SBAR(); }while(0)
  #define SIDE_WAIT() do{ if(SIDE_ST(sj_c-1)||SIDE_ST(sj_c-2)){WAIT_BAR(8);}else{WAIT_BAR(4);} }while(0)
  int sl_prev=0,sl_cur=0,sl_next=SLOTB;
  #define ROT() do{sl_prev=sl_cur;sl_cur=sl_next;sl_next=(sl_next==(NSLOT-1)*SLOTB)?0:sl_next+SLOTB;}while(0)
  DMA_K(2,2*SLOTB);
  WAIT_BAR(3);
  qkt(pA0,pA1,Kbase,qr,negm,r32,hi);asm volatile("s_nop 15\n\ts_nop 7":"+v"(pA0),"+v"(pA1));CMASK(pA0,pA1,0);
  START(pA0,pA1);
  _Pragma("unroll") for(int r=0;r<16;++r)pA1[r]=__builtin_amdgcn_exp2f(pA1[r]);
  WAIT_BAR(0);
  DMA_K(3,0);DMA_V(1,SLOTB);
  if constexpr(SIDE){ SIDE_LD(); SIDE_CV(); }
  ROT();
  kload8(kf,kp0+sl_cur);
  if constexpr(SIDE){WAIT_BAR(3);}else{WAIT_BAR(2);}
  s16x4 vlo[8],vhi[8]; u32x4 pw0,pw1,pw2,pw3;
  #define PKW(P,B) cvtpk_s(P[B],P[B+1])
  #define PAF(k) __builtin_bit_cast(bf16x8,pw##k)
  #define VFR(i) (bf16x8){vlo[i][0],vlo[i][1],vlo[i][2],vlo[i][3],vhi[i][0],vhi[i][1],vhi[i][2],vhi[i][3]}
  #define PIN(x) asm volatile("":"+v"(x))
  #define MX3(a,b,c) __builtin_fmaxf(__builtin_fmaxf((a),(b)),(c))
  #define GAPA(MF,A0,A1,A2,A3,W0,W1,PW) do{ MF; sacc+=A0; sacc+=A1; sacc+=A2; sacc+=A3; PIN(sacc); W0; W1; PIN(PW); SBAR(); }while(0)
  #define EX(v) __builtin_amdgcn_exp2f(v)
  #define GAPB(MF,X,B) do{ MF; X[B]=EX(X[B]); X[B+1]=EX(X[B+1]); X[B+2]=EX(X[B+2]); X[B+3]=EX(X[B+3]); PIN(X); SBAR(); }while(0)
  #define VRD(i) do{ vlo[i]=vtr(vp_+(((i)>>2)*4096+((i)&3)*1024)); vhi[i]=vtr(vp_+(((i)>>2)*4096+((i)&3)*1024+512)); }while(0)
  #define KRD(G,j) do{ if(G){ kload2(kf,kp0+sl_next,j); SBAR(); } }while(0)
  #define STEP(C0,C1,P0,P1,t,GK,GV,GL,SD) do{ SBAR(); if constexpr(SD){ SIDE_RD(); if(GK){DMA_K((t)+3,sl_cur);} if(GV){DMA_V((t)+1,sl_next);} SIDE_LD(); SBAR(); } \
    const lds_cptr vp_=vp0+sl_prev; \
    VRD(0); SBAR(); float sacc=(P0[0]+P0[1]); \
    GAPA(C0=__builtin_amdgcn_mfma_f32_32x32x16_bf16(kf[0],qr[0],negm,0,0,0), P0[2],P0[3],P0[4],P0[5],     pw0[0]=PKW(P0,0), pw0[1]=PKW(P0,2), pw0); \
    VRD(4); SBAR(); GAPA(C1=__builtin_amdgcn_mfma_f32_32x32x16_bf16(kf[1],qr[0],negm,0,0,0), P0[6],P0[7],P0[8],P0[9],     pw0[2]=PKW(P0,4), pw0[3]=PKW(P0,6), pw0); \
    VRD(1); SBAR(); GAPA(C0=__builtin_amdgcn_mfma_f32_32x32x16_bf16(kf[2],qr[1],C0,0,0,0),   P0[10],P0[11],P0[12],P0[13], pw1[0]=PKW(P0,8), pw1[1]=PKW(P0,10), pw1); \
    VRD(5); SBAR(); GAPA(C1=__builtin_amdgcn_mfma_f32_32x32x16_bf16(kf[3],qr[1],C1,0,0,0),   P0[14],P0[15],P1[0],P1[1],   pw1[2]=PKW(P0,12),pw1[3]=PKW(P0,14), pw1); \
    VRD(2); SBAR(); GAPA(C0=__builtin_amdgcn_mfma_f32_32x32x16_bf16(kf[4],qr[2],C0,0,0,0),   P1[2],P1[3],P1[4],P1[5],     pw2[0]=PKW(P1,0), pw2[1]=PKW(P1,2), pw2); \
    VRD(6); SBAR(); GAPA(C1=__builtin_amdgcn_mfma_f32_32x32x16_bf16(kf[5],qr[2],C1,0,0,0),   P1[6],P1[7],P1[8],P1[9],     pw2[2]=PKW(P1,4), pw2[3]=PKW(P1,6), pw2); \
    VRD(3); SBAR(); GAPA(C0=__builtin_amdgcn_mfma_f32_32x32x16_bf16(kf[6],qr[3],C0,0,0,0),   P1[10],P1[11],P1[12],P1[13], pw3[0]=PKW(P1,8), pw3[1]=PKW(P1,10), pw3); \
    VRD(7); SBAR(); GAPA(C1=__builtin_amdgcn_mfma_f32_32x32x16_bf16(kf[7],qr[3],C1,0,0,0),   P1[14],P1[15],0.f,0.f,       pw3[2]=PKW(P1,12),pw3[3]=PKW(P1,14), pw3); \
    l_reg+=sacc; \
    if constexpr(SD){ SIDE_CV(); }else{ if(GK){DMA_K((t)+3,sl_cur);} if(GV){DMA_V((t)+1,sl_next);} } \
    CMASK(C0,C1,t); \
    if constexpr(!NOMAX){ float a=MX3(C0[0],C0[1],C1[0]),b=MX3(C0[2],C0[3],C1[1]); a=MX3(a,C1[2],C1[3]); \
      _Pragma("unroll") for(int r=4;r<16;r+=4){a=MX3(a,C0[r],C0[r+1]);b=MX3(b,C0[r+2],C0[r+3]);a=MX3(a,C1[r],C1[r+1]);b=MX3(b,C1[r+2],C1[r+3]);} \
      float rm=__builtin_fmaxf(a,b); { auto rr=__builtin_amdgcn_permlane32_swap(__float_as_uint(rm),__float_as_uint(rm),false,false); rm=__builtin_fmaxf(__uint_as_float(rr[0]),__uint_as_float(rr[1])); } \
      resc=false; \
      if(__builtin_expect(__any(rm>(float)THRL),0)){ const float dl=__builtin_fmaxf(rm,0.f); mhat+=dl; \
        _Pragma("unroll") for(int r=0;r<16;++r){C0[r]-=dl;C1[r]-=dl;} \
        if constexpr(MODE!=1){ _Pragma("unroll") for(int r=0;r<16;++r)negm[r]=-mhat; asm volatile("":"+v"(negm)); } \
        const float f=__builtin_amdgcn_exp2f(-dl); l_reg*=f; if(hi==0)wsf[r32]=f; resc=true; } } \
    SBAR(); \
    GAPB(o[0]=__builtin_amdgcn_mfma_f32_32x32x16_bf16(PAF(0),VFR(0),o[0],0,0,0), C0,0); \
    GAPB(o[1]=__builtin_amdgcn_mfma_f32_32x32x16_bf16(PAF(0),VFR(4),o[1],0,0,0), C0,4); \
    KRD(GL,0); GAPB(o[0]=__builtin_amdgcn_mfma_f32_32x32x16_bf16(PAF(1),VFR(1),o[0],0,0,0), C0,8); \
    KRD(GL,1); GAPB(o[1]=__builtin_amdgcn_mfma_f32_32x32x16_bf16(PAF(1),VFR(5),o[1],0,0,0), C0,12); \
    KRD(GL,2); GAPB(o[0]=__builtin_amdgcn_mfma_f32_32x32x16_bf16(PAF(2),VFR(2),o[0],0,0,0), C1,0); \
    KRD(GL,3); GAPB(o[1]=__builtin_amdgcn_mfma_f32_32x32x16_bf16(PAF(2),VFR(6),o[1],0,0,0), C1,4); \
    GAPB(o[0]=__builtin_amdgcn_mfma_f32_32x32x16_bf16(PAF(3),VFR(3),o[0],0,0,0), C1,8); \
    GAPB(o[1]=__builtin_amdgcn_mfma_f32_32x32x16_bf16(PAF(3),VFR(7),o[1],0,0,0), C1,12); \
    }while(0)
  int t=1;
  asm volatile(".p2align 6");
  for(;t+5<NT;t+=2){
    STEP(pB0,pB1,pA0,pA1,t,true,true,true,SIDE);     if constexpr(SIDE){SIDE_WAIT();}else{WAIT_BAR(2);} RESC(); ROT();
    STEP(pA0,pA1,pB0,pB1,t+1,true,true,true,SIDE);   if constexpr(SIDE){SIDE_WAIT();}else{WAIT_BAR(2);} RESC(); ROT();
  }
  #define ENDW(tt) do{ if((tt)+3<NT){WAIT_BAR(2);} else if((tt)+2<NT){WAIT_BAR(1);} else {WAIT_BAR(0);} }while(0)
  for(;t+1<NT;t+=2){
    STEP(pB0,pB1,pA0,pA1,t,(t+3<NT),(t+1<NT),(t+1<NT),false);       ENDW(t);   RESC(); ROT();
    STEP(pA0,pA1,pB0,pB1,t+1,(t+4<NT),(t+2<NT),(t+2<NT),false);     ENDW(t+1); RESC(); ROT();
  }
  #define DRAIN(D0,D1,VSL) do{ float sacc=D0[0]+D0[1]; _Pragma("unroll") for(int r=2;r<16;++r)sacc+=D0[r]; _Pragma("unroll") for(int r=0;r<16;++r)sacc+=D1[r]; l_reg+=sacc; \
    pw0=(u32x4){PKW(D0,0),PKW(D0,2),PKW(D0,4),PKW(D0,6)};pw1=(u32x4){PKW(D0,8),PKW(D0,10),PKW(D0,12),PKW(D0,14)};pw2=(u32x4){PKW(D1,0),PKW(D1,2),PKW(D1,4),PKW(D1,6)};pw3=(u32x4){PKW(D1,8),PKW(D1,10),PKW(D1,12),PKW(D1,14)}; \
    SBAR(); pv(o,vb0+(VSL),PAF(0),PAF(1),PAF(2),PAF(3)); }while(0)
  if constexpr(ODD){ DRAIN(pA0,pA1,sl_prev); }
  else{ STEP(pB0,pB1,pA0,pA1,NT-1,false,false,false,false); RESC(); DRAIN(pB0,pB1,sl_cur); }
  #undef DRAIN
  #undef PKW
  #undef PAF
  #undef VFR
  #undef PIN
  #undef MX3
  #undef GAPA
  #undef GAPB
  #undef EX
  #undef VRD
  #undef KRD
  #undef STEP
  #undef SIDE_RD
  #undef SIDE_LD
  #undef SIDE_CV
  #undef SIDE_ST
  #undef SIDE_WAIT
  #undef ENDW
  {auto rr=__builtin_amdgcn_permlane32_swap(__float_as_uint(l_reg),__float_as_uint(l_reg),false,false);l_reg=__uint_as_float(rr[0])+__uint_as_float(rr[1]);}
  if(hi==0)wsf[32+r32]=l_reg;asm volatile("s_waitcnt lgkmcnt(0)":::"memory");
  float rli[16];
  #pragma unroll
  for(int r=0;r<16;++r)rli[r]=__builtin_amdgcn_rcpf(wsf[32+crow(r,hi)]);
  bf16*Ow=O+(rowbase+q0+wid*QBLK)*PQ+hq*D;
  { bf16*stg=(bf16*)(shm+LDS_OST)+wid*2048;
    #pragma unroll
    for(int r=0;r<16;++r){const int orow=crow(r,hi);
      #pragma unroll
      for(int d0=0;d0<2;++d0)stg[orow*64+d0*32+r32]=__float2bfloat16(o[d0][r]*rli[r]);}
    asm volatile("s_waitcnt lgkmcnt(0)":::"memory");
    #pragma unroll
    for(int i=0;i<4;++i){const int row=i*8+(lane>>3),ch=lane&7; const u32x4 v=*(const u32x4*)(stg+row*64+ch*8); ATTN_STORE16(Ow+(long)row*PQ+ch*8,v);} }
  asm volatile("s_waitcnt lgkmcnt(0)\n\ts_barrier":::"memory");
  #undef DMA_K
  #undef DMA_V
  #undef CMASK
  #undef START
  #undef RESC
  #undef ROT
}
constexpr int ATTN_LDS_BYTES=LDS_BYTES;
#undef SBAR
#undef WAIT_BAR
}

constexpr int NWAVES = 8;
constexpr int BATCH = 2, SEQ = 8192, D = 1024, M = BATCH * SEQ, FF = 3584, NE = 8;
constexpr int NQKV0 = 3 * D, NQKV1 = D + 2 * 256, NKV = 256, HD = 64;
constexpr float EPS = 1e-6f;
constexpr float LOG2E = 1.4426950408889634f;
constexpr int NCHUNK = M / 64;
constexpr int MOE_MAXT = 135;
constexpr float Y8_SCALE = 16.f;
constexpr float WGU_SCALE = 64.f, WD_SCALE = 128.f;

constexpr size_t MiB = 1u << 20;
constexpr size_t WS_CTL = 0, CTL_ZERO_BYTES = 64 * 1024;
constexpr size_t WS_ROPE = 1 * MiB;
constexpr size_t WS_TOKE = 1 * MiB + 256 * 1024;
constexpr size_t WS_TOKG = 1 * MiB + 512 * 1024;
constexpr size_t WS_SLOT = 1 * MiB + 768 * 1024;
constexpr size_t WS_CCNT = 2 * MiB;
constexpr size_t WS_RS = 2 * MiB + 64 * 1024;
constexpr size_t WS_WGUM = 4 * MiB;
constexpr size_t WS_WDM = 60 * MiB;
constexpr size_t WS_WQKV0 = 88 * MiB, WS_WO0 = 94 * MiB, WS_WQKV1 = 96 * MiB, WS_WO1 = 99 * MiB, WS_WGU0 = 101 * MiB, WS_WD0 = 115 * MiB;
constexpr size_t WS_XN = 122 * MiB, WS_Q = 154 * MiB, WS_K = 186 * MiB, WS_V = 218 * MiB, WS_PO = 250 * MiB, WS_ACT = 282 * MiB;
constexpr size_t WS_XN8 = 394 * MiB;
constexpr size_t WS_APERM = 410 * MiB;
constexpr size_t WS_MACT = 122 * MiB;
constexpr size_t WS_Y = 282 * MiB;
constexpr size_t WS_YP = 350 * MiB;
constexpr int P16_KS = 7;
constexpr size_t WS_END = 444 * MiB;
static_assert(WS_WGUM + (size_t)NE * 2 * FF * D <= WS_WDM && WS_WDM + (size_t)NE * D * FF <= WS_WQKV0 && WS_WD0 + (size_t)D * FF * 2 <= WS_XN, "weight map");
static_assert(WS_ACT + (size_t)M * FF * 2 <= WS_XN8 && WS_XN8 + (size_t)M * D <= WS_APERM && WS_APERM + (size_t)MOE_MAXT * 256 * D <= WS_END, "activation map");
static_assert(WS_MACT + (size_t)MOE_MAXT * 256 * FF <= WS_PO && WS_Y + (size_t)MOE_MAXT * 256 * D * 2 <= WS_YP && WS_YP + (size_t)256 * 256 * 256 * 2 <= WS_XN8 && (FF / 128) % P16_KS == 0 && (FF / 128 / P16_KS) % 2 == 0, "MoE overlays");
constexpr int CW_TMO = 0;
constexpr int CW_BAR = 1024;

constexpr int RING_OFF = 0, RING_BYTES = 131072;
constexpr int SCR_WAVE = 64 * 65 * 4;
constexpr int NA_TAB_OFF = 90112;
constexpr int LDSCTL_OFF = 135168, MISC_WORDS = 256;
constexpr int LDS_BYTES = 147456;
static_assert(8 * SCR_WAVE <= LDSCTL_OFF && LDSCTL_OFF + MISC_WORDS * 4 <= LDS_BYTES && NA_TAB_OFF + 4 * 15 * 132 * 4 + 15 * 31 * 4 <= RING_BYTES && (D * 8) % (NWAVES * 64) == 0 && ((M / 64) * 8) % (NWAVES * 64) == 0, "LDS map");
constexpr int MW_BAR = 8;
constexpr int MW_TS = 16;
constexpr int MW_CNT = 32;
constexpr int MW_LT = 48;
#define GAS __attribute__((address_space(1)))
#define LAS __attribute__((address_space(3)))
typedef unsigned short bf16;
typedef unsigned v4u __attribute__((ext_vector_type(4)));
typedef float f32x4 __attribute__((ext_vector_type(4)));
typedef short bf16x8 __attribute__((ext_vector_type(8)));
typedef GAS unsigned gu32;
typedef GAS unsigned long long gu64;
#define RLX_AGENT __ATOMIC_RELAXED, __HIP_MEMORY_SCOPE_AGENT
#define LDS_WAIT() asm volatile("s_waitcnt lgkmcnt(0)" ::: "memory")
#define VM_WAIT() asm volatile("s_waitcnt vmcnt(0)" ::: "memory")
__device__ __forceinline__ unsigned long long rt() { return __builtin_amdgcn_s_memrealtime(); }
__device__ __forceinline__ unsigned f2bf(float f) { unsigned u = __builtin_bit_cast(unsigned, f); return (u + 0x7fffu + ((u >> 16) & 1u)) >> 16; }
__device__ __forceinline__ unsigned pk2(float lo, float hi) { return f2bf(lo) | (f2bf(hi) << 16); }

#define XB_TMO      128
#define XB_XCNT(j)  (256  + 64 * (j))
#define XB_XSUB(j)  (1280 + 64 * (j))
#define XB_XGEN(j)  (2304 + 64 * (j))
#define XB_TOP      3328
#define XB_TOPGEN   3392
#define XCD_BAR_WORDS 3456
#define XB_SPIN_CAP (1u << 18)

__device__ __forceinline__ unsigned xb_ld(unsigned* p)              { return __hip_atomic_load(p, __ATOMIC_RELAXED, __HIP_MEMORY_SCOPE_AGENT); }
__device__ __forceinline__ unsigned xb_add(unsigned* p, unsigned v) { return __hip_atomic_fetch_add(p, v, __ATOMIC_RELAXED, __HIP_MEMORY_SCOPE_AGENT); }
__device__ __forceinline__ unsigned xb_xcc_id() { return (unsigned)__builtin_amdgcn_s_getreg((3 << 11) | 20) & 0xFu; }
#define XB_SPIN(cond, bar) do { unsigned _sp = 0; while (cond) { __builtin_amdgcn_s_sleep(1); \
    if ((++_sp & 255u) == 0u) { if (xb_ld(&(bar)[XB_TMO])) break; if (_sp > XB_SPIN_CAP) { atomicAdd(&(bar)[XB_TMO], 1u); break; } } } } while (0)

struct XcdBarrier {
    unsigned* bar; unsigned x;
    volatile LAS unsigned* st;
};

__device__ __forceinline__ XcdBarrier xcd_barrier_post(unsigned* bar, volatile LAS unsigned* st) {
    XcdBarrier b; b.bar = bar; b.x = xb_xcc_id(); b.st = st;
    if (threadIdx.x == 0) (void)xb_add(&bar[XB_XCNT(b.x)], 1u);
    return b;
}
__device__ __forceinline__ void xcd_barrier_complete(unsigned* bar, unsigned x, unsigned& nloc, unsigned& nx) {
    const unsigned G = gridDim.x * gridDim.y * gridDim.z;
    unsigned sum, cnt, mine, sp = 0u;
    for (;;) {
        sum = 0u; cnt = 0u; mine = 0u;
#pragma unroll
        for (unsigned j = 0; j < 16; ++j) { const unsigned c = xb_ld(&bar[XB_XCNT(j)]); sum += c; cnt += (c > 0u) ? 1u : 0u; mine = (j == x) ? c : mine; }
        if (sum == G) break;
        __builtin_amdgcn_s_sleep(1);
        if ((++sp & 255u) == 0u) { if (xb_ld(&bar[XB_TMO])) break; if (sp > XB_SPIN_CAP) { atomicAdd(&bar[XB_TMO], 1u); break; } }
    }
    nloc = mine > 0u ? mine : 1u; nx = cnt > 0u ? cnt : 1u;
}

__device__ __forceinline__ void xcd_barrier(const XcdBarrier& b) {
    asm volatile("s_waitcnt vmcnt(0)" ::: "memory");
    __syncthreads();
    if (threadIdx.x == 0) {
        unsigned* bar = b.bar;
        __builtin_amdgcn_s_waitcnt(0);
        unsigned nloc = b.st[0], nx = b.st[1];
        if (nloc == 0u) { xcd_barrier_complete(bar, b.x, nloc, nx); b.st[0] = nloc; b.st[1] = nx; }
        const unsigned old = xb_add(&bar[XB_XSUB(b.x)], 1u);
        const unsigned gen = old / nloc;
        if (old + 1u == (gen + 1u) * nloc) {
            __builtin_amdgcn_fence(__ATOMIC_RELEASE, "agent");
            asm volatile("s_waitcnt vmcnt(0)" ::: "memory");
            const unsigned og = xb_add(&bar[XB_TOP], 1u);
            const unsigned tg = og / nx;
            if (og + 1u == (tg + 1u) * nx) xb_add(&bar[XB_TOPGEN], 1u);
            else XB_SPIN(xb_ld(&bar[XB_TOPGEN]) == tg, bar);
            __builtin_amdgcn_fence(__ATOMIC_ACQUIRE, "agent");
            xb_add(&bar[XB_XGEN(b.x)], 1u);
            asm volatile("s_waitcnt vmcnt(0)" ::: "memory");
        } else {
            XB_SPIN(xb_ld(&bar[XB_XGEN(b.x)]) == gen, bar);
            __builtin_amdgcn_fence(__ATOMIC_ACQUIRE, "agent");
            asm volatile("s_waitcnt vmcnt(0)" ::: "memory");
        }
    }
    __syncthreads();
}

typedef unsigned u32x2 __attribute__((ext_vector_type(2)));
struct Frame {
    LAS unsigned char* lds;
    volatile LAS unsigned* MISC;
    gu32* ctl;
    int tid, lane, wave;
    int vcu, G;
    unsigned char* ws;
};
__device__ __forceinline__ float wave_sum(float v) {
#pragma unroll
    for (int o = 1; o < 64; o <<= 1) v += __shfl_xor(v, o);
    return v;
}
__device__ __forceinline__ f32x4 ld_bf16x4(const bf16* p) { const u32x2 w = *(const GAS u32x2*)p;
    return (f32x4){__uint_as_float(w.x << 16), __uint_as_float(w.x & 0xffff0000u), __uint_as_float(w.y << 16), __uint_as_float(w.y & 0xffff0000u)}; }
__device__ __forceinline__ f32x4 ld_fp8x4(const unsigned char* p) { const int w = *(const GAS int*)p;
    return (f32x4){__builtin_amdgcn_cvt_f32_fp8(w, 0), __builtin_amdgcn_cvt_f32_fp8(w, 1), __builtin_amdgcn_cvt_f32_fp8(w, 2), __builtin_amdgcn_cvt_f32_fp8(w, 3)}; }
__device__ __forceinline__ void st_bf16x4(bf16* p, f32x4 v) { u32x2 w; w.x = pg8::cvt_pk_bf16(v.x, v.y); w.y = pg8::cvt_pk_bf16(v.z, v.w); *(GAS u32x2*)p = w; }
__device__ __forceinline__ float ssq4(const f32x4 (&v)[4]) { float s = 0.f;
#pragma unroll
    for (int j = 0; j < 4; ++j) s += (v[j].x * v[j].x + v[j].y * v[j].y) + (v[j].z * v[j].z + v[j].w * v[j].w);
    return wave_sum(s); }
__device__ __forceinline__ float rms_scale(float ss, int n) { return 1.0f / sqrtf(ss * (1.0f / (float)n) + EPS); }

struct TrDesc { const float* src; unsigned char* dst; int N, K, drow0, k0, n0, f8, perm; float scale; };
template <bool F8> __device__ __forceinline__ void tr_load(const TrDesc& d, f32x4 (&v)[16], int lane) {
    const int lr = lane >> 4, lc = (lane & 15) * 4;
    const float* p = d.src + (size_t)d.k0 * d.N + d.n0 + lc;
    if constexpr (F8) {
#pragma unroll
        for (int i = 0; i < 16; ++i) v[i] = *(const GAS f32x4*)(p + (size_t)(16 * (i >> 2) + 4 * lr + (i & 3)) * d.N);
    } else {
#pragma unroll
        for (int i = 0; i < 16; ++i) v[i] = *(const GAS f32x4*)(p + (size_t)(8 * (i >> 1) + 2 * lr + (i & 1)) * d.N);
    }
}
template <bool F8> __device__ __forceinline__ void tr_store(const TrDesc& d, const f32x4 (&v)[16], LAS unsigned* scr, int lane) {
    const int lr = lane >> 4, lc = (lane & 15) * 4;
    if constexpr (F8) {
        const float s = d.scale;
#pragma unroll
        for (int i = 0; i < 4; ++i) { LAS unsigned* q = scr + (4 * i + lr) * 65 + lc;
#pragma unroll
            for (int c = 0; c < 4; ++c) q[c] = pg8::cvt4_fp8(v[4 * i][c] * s, v[4 * i + 1][c] * s, v[4 * i + 2][c] * s, v[4 * i + 3][c] * s); }
        LDS_WAIT(); asm volatile("" ::: "memory");
        const int c4 = lane & 3, nn = lane >> 2;
#pragma unroll
        for (int j = 0; j < 4; ++j) { const int n = nn + 16 * j; const LAS unsigned* q = scr + (4 * c4) * 65 + n;
            v4u o; o.x = q[0]; o.y = q[65]; o.z = q[130]; o.w = q[195];
            *(GAS v4u*)(d.dst + (size_t)(d.drow0 + n) * d.K + d.k0 + 16 * c4) = o; }
    } else {
#pragma unroll
        for (int i = 0; i < 8; ++i) { LAS unsigned* q = scr + (4 * i + lr) * 65 + lc;
#pragma unroll
            for (int c = 0; c < 4; ++c) q[c] = pg8::cvt_pk_bf16(v[2 * i][c], v[2 * i + 1][c]); }
        LDS_WAIT(); asm volatile("" ::: "memory");
        const int c8 = lane & 7, nn = lane >> 3;
#pragma unroll
        for (int j = 0; j < 8; ++j) { const int n = nn + 8 * j; const LAS unsigned* q = scr + (4 * c8) * 65 + n;
            v4u o; o.x = q[0]; o.y = q[65]; o.z = q[130]; o.w = q[195];
            const int nd = d.perm ? 128 * ((n >> 4) & 1) + (n & 15) + 16 * (n >> 5) : n;
            *(GAS v4u*)(d.dst + ((size_t)(d.drow0 + nd) * d.K + d.k0 + 8 * c8) * 2) = o; }
    }
    LDS_WAIT(); asm volatile("" ::: "memory");
}
__device__ __forceinline__ void tr_fill(TrDesc& d, const float* W, int K, int N, void* WT, int mode, int item, int f8, float scale) {
    const int nblk = N / 64, kb = item / nblk, nb = item % nblk, n0 = 64 * nb;
    d.src = W; d.dst = (unsigned char*)WT; d.N = N; d.K = K; d.k0 = 64 * kb; d.n0 = n0; d.f8 = f8; d.scale = scale; d.perm = 0;
    d.drow0 = mode == 0 ? n0 : ((n0 >> 7) << 8) + (n0 & 127) + (mode == 2 ? 128 : 0);
    if (mode == 3 && nb < 20) { d.perm = 1; d.drow0 = 256 * (nb >> 2) + 32 * (nb & 3); }
    else if (mode == 3) d.drow0 = n0;
}

#ifndef MOE_ALIGN
#define MOE_ALIGN PG8_ALIGN
#endif
#ifndef PROBE
#define PROBE 0
#endif
#if PROBE
#define PROBE_REP(n) for (int rep_ = 0; rep_ < ((PROBE == (n)) ? 2 : 1); ++rep_)
#else
#define PROBE_REP(n) if constexpr (constexpr int rep_ = 0; true)
#endif
struct Args { const float* in[16]; float* out; unsigned char* ws; };
enum { I_X = 0, I_NG, I_NAQKV, I_RPB, I_NAO, I_GQKV, I_QN, I_KN, I_GO, I_FG, I_FU, I_FD, I_RT, I_MG, I_MU, I_MD };

__global__ void __launch_bounds__(NWAVES * 64, 2) fwd_kernel(Args args) {
    extern __shared__ __attribute__((aligned(16))) unsigned char lds[];
    Frame F;
    F.lds = (LAS unsigned char*)lds;
    F.MISC = (volatile LAS unsigned*)(F.lds + LDSCTL_OFF);
    F.tid = threadIdx.x; F.lane = F.tid & 63; F.wave = __builtin_amdgcn_readfirstlane(F.tid >> 6);
    F.G = gridDim.x; { const int bx = blockIdx.x; F.vcu = (F.G % 8 == 0) ? (bx % 8) * (F.G / 8) + bx / 8 : bx; }
    F.ws = args.ws; F.ctl = (gu32*)(args.ws + WS_CTL);
    unsigned char* const ws = args.ws;
    for (int u = F.tid; u < MISC_WORDS; u += NWAVES * 64) F.MISC[u] = 0u;
    __syncthreads();
    XcdBarrier bar = xcd_barrier_post((unsigned*)(F.ctl + CW_BAR), F.MISC + MW_BAR);
#define GRID_BAR() xcd_barrier(bar)

    const float* x = args.in[I_X]; const float* norm_g = args.in[I_NG]; float* out = args.out;
    bf16* XN = (bf16*)(ws + WS_XN); bf16* QB = (bf16*)(ws + WS_Q); bf16* KB = (bf16*)(ws + WS_K); bf16* VB = (bf16*)(ws + WS_V); bf16* PO = (bf16*)(ws + WS_PO); bf16* HB = PO;
    bf16* ACT = (bf16*)(ws + WS_ACT); unsigned char* XN8 = ws + WS_XN8; unsigned char* APERM = ws + WS_APERM; unsigned char* MACT = ws + WS_MACT; unsigned char* Y8 = ws + WS_Y; bf16* YP = (bf16*)(ws + WS_YP);
    int* tok_e = (int*)(ws + WS_TOKE); float* tok_g = (float*)(ws + WS_TOKG); int* slot_of = (int*)(ws + WS_SLOT); int* ccnt = (int*)(ws + WS_CCNT);
    float* rope_tab = (float*)(ws + WS_ROPE); float* RS0 = (float*)(ws + WS_RS); float* RS1 = RS0 + M; float* RS2 = RS1 + M;
    const int NGW = F.G * NWAVES;
    constexpr int I_A = 16 * 48, I_B = 16 * 16, I_C = 16 * 24, I_D = 16 * 16, I_E = 16 * 56, I_F = 56 * 16;
    constexpr int NDENSE = I_A + I_B + I_C + I_D + 2 * I_E + I_F, NGU = NE * 2 * I_E;
    constexpr int SJ_NPIECE = NE * 2 * (FF / 32) * (D / attn_body::SJ_PK), SJ_CNT = SJ_NPIECE / (256 * NWAVES), SJ_LDS = attn_body::ATTN_LDS_BYTES;
    static_assert(SJ_CNT * 256 * NWAVES == SJ_NPIECE && SJ_CNT % 16 == 0 && SJ_CNT + 3 <= SEQ / 64 - 6 && attn_body::SJ_K == D && attn_body::SJ_N == FF && SJ_LDS + NWAVES * attn_body::SJ_STAGE <= LDSCTL_OFF, "side job");
    const bool side_on = F.G == 256;
    const bool side_real = side_on && attn_body::SJ_MODE == 0;
#define PHASE_IDS() int lane = F.tid & 63; asm volatile("" : "+v"(lane)); const int wave = F.wave; const int colb = 4 * lane; const int gw = F.vcu * NWAVES + wave; \
        const bool xal_ = F.G % 8 == 0 && (M / 8) % (NGW / 8) == 0; const int xrs = xal_ ? NGW / 8 : NGW, xr0 = xal_ ? (gw / (NGW / 8)) * (M / 8) + gw % (NGW / 8) : gw, xre = xal_ ? (gw / (NGW / 8) + 1) * (M / 8) : M

    PROBE_REP(100) {
    {
        PHASE_IDS();
        LAS unsigned* scr = (LAS unsigned*)(F.lds + RING_OFF + wave * SCR_WAVE);
#define TR_DECODE_BF(d, it_) do { int r = (it_); \
            if (r < I_A) { tr_fill(d, args.in[I_NAQKV], D, NQKV0, ws + WS_WQKV0, 0, r, 0, 1.f); break; } r -= I_A; \
            if (r < I_B) { tr_fill(d, args.in[I_NAO], D, D, ws + WS_WO0, 0, r, 0, 1.f); break; } r -= I_B; \
            if (r < I_C) { tr_fill(d, args.in[I_GQKV], D, NQKV1, ws + WS_WQKV1, 3, r, 0, 1.f); break; } r -= I_C; \
            if (r < I_D) { tr_fill(d, args.in[I_GO], D, D, ws + WS_WO1, 0, r, 0, 1.f); break; } r -= I_D; \
            if (r < I_E) { tr_fill(d, args.in[I_FG], D, FF, ws + WS_WGU0, 1, r, 0, 1.f); break; } r -= I_E; \
            if (r < I_E) { tr_fill(d, args.in[I_FU], D, FF, ws + WS_WGU0, 2, r, 0, 1.f); break; } r -= I_E; \
            tr_fill(d, args.in[I_FD], FF, D, ws + WS_WD0, 0, r, 0, 1.f); } while (0)
#define TR_DECODE_F8(d, it_) do { int r = (it_); \
            if (r < NGU) { const int e = r / (2 * I_E), q = r % (2 * I_E), up = q >= I_E ? 1 : 0; \
                tr_fill(d, (up ? args.in[I_MU] : args.in[I_MG]) + (size_t)e * D * FF, D, FF, ws + WS_WGUM + (size_t)e * 2 * FF * D, 1 + up, q - up * I_E, 1, WGU_SCALE); break; } r -= NGU; \
            { const int e = r / I_F; tr_fill(d, args.in[I_MD] + (size_t)e * FF * D, FF, D, ws + WS_WDM + (size_t)e * D * FF, 0, r % I_F, 1, WD_SCALE); } } while (0)
#define TR_LOOP(F8_, DEC, NIT, IT0, STRIDE) do { int it = (IT0); TrDesc dA, dB; f32x4 vA[16], vB[16]; bool hA = it < (NIT); \
            if (hA) { DEC(dA, it); tr_load<F8_>(dA, vA, lane); } \
            while (hA) { \
                const int i1 = it + (STRIDE); const bool hB = i1 < (NIT); \
                { DEC(dB, hB ? i1 : it); tr_load<F8_>(dB, vB, lane); }     \
                tr_store<F8_>(dA, vA, scr, lane); \
                if (!hB) break; \
                const int i2 = i1 + (STRIDE); hA = i2 < (NIT); \
                { DEC(dA, hA ? i2 : i1); tr_load<F8_>(dA, vA, lane); } \
                tr_store<F8_>(dB, vB, scr, lane); \
                it = i2; \
            } } while (0)
        TR_LOOP(false, TR_DECODE_BF, NDENSE, gw, NGW);
        if (!side_real) TR_LOOP(true, TR_DECODE_F8, NGU, (gw + NGW - (NDENSE % NGW)) % NGW, NGW);
#undef TR_DECODE_BF
        for (int id = (int)blockIdx.x * (NWAVES * 64) + F.tid; id < 128 * 16; id += F.G * NWAVES * 64) {
            const int pos = id >> 4, i = id & 15; const float fr = exp2f(-(float)i * (13.287712379549449f / 16.0f)); const float ang = (float)pos * fr;
            rope_tab[2 * id] = cosf(ang); rope_tab[2 * id + 1] = sinf(ang);
        }
        f32x4 g0[4];
#pragma unroll
        for (int j = 0; j < 4; ++j) g0[j] = *(const GAS f32x4*)(norm_g + 0 * D + colb + 256 * j);
        {
#define XN_LOAD(V_, m_) do { _Pragma("unroll") for (int j = 0; j < 4; ++j) V_[j] = *(const GAS f32x4*)(x + (size_t)(m_) * D + colb + 256 * j); } while (0)
#define XN_DO(V_, m_) do { const float r = rms_scale(ssq4(V_), D); if (lane == 0) RS0[(m_)] = 1.0f / r; _Pragma("unroll") for (int j = 0; j < 4; ++j) st_bf16x4(XN + (size_t)(m_) * D + colb + 256 * j, V_[j] * r * g0[j]); } while (0)
            f32x4 vA[4], vB[4]; int m = xr0; bool hA = m < xre;
            if (hA) XN_LOAD(vA, m);
            while (hA) {
                const int m1 = m + xrs; const bool hB = m1 < xre; XN_LOAD(vB, hB ? m1 : m);
                XN_DO(vA, m);
                if (!hB) break;
                const int m2 = m1 + xrs; hA = m2 < xre; XN_LOAD(vA, hA ? m2 : m1);
                XN_DO(vB, m1);
                m = m2;
            }
#undef XN_LOAD
#undef XN_DO
        }
    }
    GRID_BAR();
    }

    PROBE_REP(1) {
    {
        pg8::Gemm g{XN, (const bf16*)(ws + WS_WQKV0), M, NQKV0, D, 0}; pg8::StaticOrder S; S.init(M, NQKV0, F.G, (int)blockIdx.x);
        pg8::EpiBf16<0> E{QB, D, nullptr, D, (size_t)(WS_K - WS_Q) / 2, attn_body::C2};
        pg8::gemm_phase<pg8::EpiBf16<0>, pg8::StaticOrder, PG8_ALIGN, PG8_SP2>(F.lds + RING_OFF, g, S, E);
    }
    GRID_BAR();
    }

    PROBE_REP(2) {
    {
        attn_body::lds_fptr tab = (attn_body::lds_fptr)(F.lds + NA_TAB_OFF);
        const int upc = (1024 + F.G - 1) / F.G; int cur_h = -1;
        for (int i = 0; i < upc; ++i) {
            const int id = F.vcu * upc + i; if (id >= 1024) break;
            const int bh = id >> 5, qb4 = id & 31, b = bh >> 4, h = bh & 15, r0 = 4 * qb4;
            if (h != cur_h) {
                const float* rp = args.in[I_RPB] + (size_t)h * 15 * 31;
                LAS float* raw = (LAS float*)(F.lds + NA_TAB_OFF) + 4 * attn_body::NA_TCOPY;
                if (F.tid < 15 * 31) raw[F.tid] = rp[F.tid] * LOG2E;
                LDS_WAIT(); __syncthreads();
                for (int u = F.tid; u < 4 * attn_body::NA_TCOPY; u += NWAVES * 64) { const int s = u / attn_body::NA_TCOPY, rem = u % attn_body::NA_TCOPY, ro = rem / attn_body::NA_TROW, x = rem % attn_body::NA_TROW - s, dc = x - 64;
                    const float v = (x >= 0 && dc >= -15 && dc <= 15) ? raw[ro * 31 + dc + 15] : 0.f;
                    ((LAS float*)(F.lds + NA_TAB_OFF))[u] = v; }
                cur_h = h; LDS_WAIT(); __syncthreads();
            }
            int first = r0 - 4; first = first < 0 ? 0 : (first > 117 ? 117 : first);
            attn_body::attn_unit<1, 1024, 1024, 8, false, true>(b, h, h, 64 * r0, 64 * first, 11, (const attn_body::bf16*)QB, (const attn_body::bf16*)KB, (const attn_body::bf16*)VB, (attn_body::bf16*)((PROBE == 2 && rep_ == 0) ? ACT : QB), (char*)lds + RING_OFF, r0, first, tab);
        }
    }
    GRID_BAR();
    }

    PROBE_REP(3) {
    {
        pg8::Gemm g{QB, (const bf16*)(ws + WS_WO0), M, D, D, 0}; pg8::StaticOrder S; S.init(M, D, F.G, (int)blockIdx.x);
        pg8::EpiBf16<0> E{PO, D, nullptr, 0, 0, 1.f};
        pg8::gemm_phase<pg8::EpiBf16<0>, pg8::StaticOrder, PG8_ALIGN, PG8_SP2>(F.lds + RING_OFF, g, S, E);
    }
    GRID_BAR();
    }

#define THIN_LOAD(P_, H_, S_, ABUF, HF32, RSIN, m_) do { _Pragma("unroll") for (int j = 0; j < 4; ++j) { P_[j] = ld_bf16x4((ABUF) + (size_t)(m_) * D + colb + 256 * j); \
            if constexpr (HF32) H_[j] = *(const GAS f32x4*)(x + (size_t)(m_) * D + colb + 256 * j); else H_[j] = ld_bf16x4(XN + (size_t)(m_) * D + colb + 256 * j); } \
            if constexpr (!(HF32)) S_ = (RSIN)[(m_)]; } while (0)
#define THIN_DO(P_, H_, S_, HF32, RSOUT, m_) do { const float r1 = rms_scale(ssq4(P_), D); \
            if constexpr (!(HF32)) { _Pragma("unroll") for (int j = 0; j < 4; ++j) H_[j] = H_[j] * (igb[j] * S_); }     \
            _Pragma("unroll") for (int j = 0; j < 4; ++j) H_[j] = H_[j] + P_[j] * r1 * ga[j]; \
            const float r2 = rms_scale(ssq4(H_), D); if (lane == 0) (RSOUT)[(m_)] = 1.0f / r2; \
            _Pragma("unroll") for (int j = 0; j < 4; ++j) st_bf16x4(XN + (size_t)(m_) * D + colb + 256 * j, H_[j] * r2 * gb[j]); } while (0)
#define THIN_RES_NORM(ABUF, HF32, GA, GB, GPREV, RSIN, RSOUT) do { \
        PHASE_IDS(); f32x4 ga[4], gb[4], igb[4]; \
        _Pragma("unroll") for (int j = 0; j < 4; ++j) { ga[j] = *(const GAS f32x4*)((GA) + colb + 256 * j); gb[j] = *(const GAS f32x4*)((GB) + colb + 256 * j); \
            if constexpr (!(HF32)) { const f32x4 gp = *(const GAS f32x4*)((GPREV) + colb + 256 * j); igb[j] = (f32x4){1.0f / gp.x, 1.0f / gp.y, 1.0f / gp.z, 1.0f / gp.w}; } else igb[j] = (f32x4){0.f, 0.f, 0.f, 0.f}; } \
        f32x4 pA[4], hA_[4], pB[4], hB_[4]; float sA = 0.f, sB = 0.f; int m = xr0; const int m0_ = xr0; bool hasA = m < xre; \
        if (hasA) THIN_LOAD(pA, hA_, sA, ABUF, HF32, RSIN, m); \
        while (hasA) {                                                     \
            const int m1 = m + xrs; const bool hasB = m1 < xre; THIN_LOAD(pB, hB_, sB, ABUF, HF32, RSIN, hasB ? m1 : m0_);     \
            THIN_DO(pA, hA_, sA, HF32, RSOUT, m); \
            if (!hasB) break; \
            const int m2 = m1 + xrs; hasA = m2 < xre; THIN_LOAD(pA, hA_, sA, ABUF, HF32, RSIN, hasA ? m2 : m0_); \
            THIN_DO(pB, hB_, sB, HF32, RSOUT, m1); \
            m = m2; \
        } } while (0)

    THIN_RES_NORM(PO, false, norm_g + 1 * D, norm_g + 2 * D, norm_g + 0 * D, RS0, RS1);
    GRID_BAR();

    PROBE_REP(5) {
    {
        pg8::Gemm g{XN, (const bf16*)(ws + WS_WGU0), M, 2 * FF, D, 0}; pg8::StaticOrder S; S.init(M, 2 * FF, F.G, (int)blockIdx.x);
        pg8::EpiSwiglu E{ACT, FF};
        pg8::gemm_phase<pg8::EpiSwiglu, pg8::StaticOrder, PG8_ALIGN, PG8_SP2>(F.lds + RING_OFF, g, S, E);
    }
    GRID_BAR();
    }

    PROBE_REP(6) {
    {
        pg8::Gemm g{ACT, (const bf16*)(ws + WS_WD0), M, D, FF, 0}; pg8::StaticOrder S; S.init(M, D, F.G, (int)blockIdx.x);
        pg8::EpiBf16<0> E{QB, D, nullptr, 0, 0, 1.f};
        pg8::gemm_phase<pg8::EpiBf16<0>, pg8::StaticOrder, PG8_ALIGN, PG8_SP2>(F.lds + RING_OFF, g, S, E);
    }
    GRID_BAR();
    }

    THIN_RES_NORM(QB, false, norm_g + 3 * D, norm_g + 4 * D, norm_g + 2 * D, RS1, RS2);
    GRID_BAR();

    PROBE_REP(8) {
    {
        pg8::Gemm g{XN, (const bf16*)(ws + WS_WQKV1), M, NQKV1, D, 0}; pg8::StaticOrder S; S.init(M, NQKV1, F.G, (int)blockIdx.x);
        pg8::EpiQkvRope E{QB, (size_t)(WS_K - WS_Q) / 2, args.in[I_QN], args.in[I_KN], rope_tab, attn_body::C2, EPS};
        pg8::gemm_phase<pg8::EpiQkvRope, pg8::StaticOrder, PG8_ALIGN, PG8_SP2>(F.lds + RING_OFF, g, S, E);
        {
            PHASE_IDS(); (void)colb; (void)gw;
            LAS unsigned* scr = (LAS unsigned*)(F.lds + RING_OFF + wave * SCR_WAVE);
            const int nun = (M / 256) * (NQKV1 / 256), rem = nun % F.G, first = rem == 0 ? 0 : rem, nidle = F.G - first;
            const int me = (int)blockIdx.x - first;
            if (me >= 0) { const int stride = nidle * NWAVES; TR_LOOP(true, TR_DECODE_F8, NGU + NE * I_F, NGU + me * NWAVES + wave, stride); }
        }
    }
    GRID_BAR();
    }
#undef TR_DECODE_F8
#undef TR_LOOP

    PROBE_REP(10) {
    {
        float gq = fabsf(args.in[I_QN][F.tid & 63]), gk = fabsf(args.in[I_KN][F.tid & 63]);
#pragma unroll
        for (int o = 1; o < 64; o <<= 1) { gq = fmaxf(gq, __shfl_xor(gq, o)); gk = fmaxf(gk, __shfl_xor(gk, o)); }
        const bool nomax = __builtin_amdgcn_readfirstlane((64.0f * 1.01f * 0.125f * LOG2E) * gq * gk < 64.0f ? 1 : 0) != 0;
        const int upc = (1024 + F.G - 1) / F.G;
        for (int i = 0; i < upc; ++i) {
            const int id = F.vcu * upc + i; if (id >= 1024) break;
            const int bk = id >> 7, loc = id & 127, b = bk >> 2, hk = bk & 3, hq = 4 * hk + (loc >> 5), qb = loc & 31;
            attn_body::bf16* Od = (attn_body::bf16*)((PROBE == 10 && rep_ == 0) ? ACT : QB);
#define GQA_UNIT(NM_, SD_) attn_body::attn_unit<0, 1024, 256, 8, NM_, false, SD_>(b, hq, hk, 256 * qb, 0, SEQ / 64, (const attn_body::bf16*)QB, (const attn_body::bf16*)KB, (const attn_body::bf16*)VB, Od, (char*)lds + RING_OFF, 0, 0, (attn_body::lds_fptr)(F.lds + NA_TAB_OFF), sj)
            const attn_body::SideJob sj{args.in[I_MG], args.in[I_MU], attn_body::SJ_MODE == 0 ? ws + WS_WGUM : ws + WS_ACT, F.vcu * NWAVES * SJ_CNT, SJ_CNT, (unsigned)(uintptr_t)((char*)lds + RING_OFF + SJ_LDS), WGU_SCALE};
            if (side_on && i == 0) { if (nomax) GQA_UNIT(true, true); else GQA_UNIT(false, true); }
            else { if (nomax) GQA_UNIT(true, false); else GQA_UNIT(false, false); }
#undef GQA_UNIT
        }
    }
    GRID_BAR();
    }

    {
        pg8::Gemm g{QB, (const bf16*)(ws + WS_WO1), M, D, D, 0}; pg8::StaticOrder S; S.init(M, D, F.G, (int)blockIdx.x);
        pg8::EpiBf16<0> E{KB, D, nullptr, 0, 0, 1.f};
        pg8::gemm_phase<pg8::EpiBf16<0>, pg8::StaticOrder, PG8_ALIGN, PG8_SP2>(F.lds + RING_OFF, g, S, E);
    }
    GRID_BAR();

    {
        PHASE_IDS();
        LAS float* wrT = (LAS float*)(F.lds + RING_OFF);
        { float t_[D * NE / (NWAVES * 64)];
#pragma unroll
            for (int i = 0; i < D * NE / (NWAVES * 64); ++i) t_[i] = args.in[I_RT][F.tid + NWAVES * 64 * i];
#pragma unroll
            for (int i = 0; i < D * NE / (NWAVES * 64); ++i) { const int u = F.tid + NWAVES * 64 * i; wrT[(u & 7) * D + (u >> 3)] = t_[i]; } }
        f32x4 ga[4], gb[4];
#pragma unroll
        for (int j = 0; j < 4; ++j) { ga[j] = *(const GAS f32x4*)(norm_g + 5 * D + colb + 256 * j); gb[j] = *(const GAS f32x4*)(norm_g + 6 * D + colb + 256 * j); }
        f32x4 igp[4];
#pragma unroll
        for (int j = 0; j < 4; ++j) { const f32x4 gp = *(const GAS f32x4*)(norm_g + 4 * D + colb + 256 * j); igp[j] = (f32x4){1.0f / gp.x, 1.0f / gp.y, 1.0f / gp.z, 1.0f / gp.w}; }
        LDS_WAIT(); __syncthreads();
        for (int c = F.vcu; c < NCHUNK; c += F.G) {
            if (F.tid < NE) F.MISC[MW_CNT + F.tid] = 0u;
            __syncthreads();
#define P12_LOAD(P_, H_, S_, m_) do { _Pragma("unroll") for (int j = 0; j < 4; ++j) { P_[j] = ld_bf16x4(KB + (size_t)(m_) * D + colb + 256 * j); H_[j] = ld_bf16x4(XN + (size_t)(m_) * D + colb + 256 * j); } S_ = RS2[(m_)]; } while (0)
#define P12_DO(p, hv, s_, m_) do { const int m = (m_); \
                const float r1 = rms_scale(ssq4(p), D); \
                _Pragma("unroll") for (int j = 0; j < 4; ++j) hv[j] = hv[j] * (igp[j] * s_);                            \
                _Pragma("unroll") for (int j = 0; j < 4; ++j) { hv[j] = hv[j] + p[j] * r1 * ga[j]; st_bf16x4(HB + (size_t)m * D + colb + 256 * j, hv[j]); } \
                const float r2 = rms_scale(ssq4(hv), D); \
                _Pragma("unroll") for (int j = 0; j < 4; ++j) { hv[j] = hv[j] * r2 * gb[j]; *(GAS unsigned*)(XN8 + (size_t)m * D + colb + 256 * j) = pg8::cvt4_fp8(hv[j].x, hv[j].y, hv[j].z, hv[j].w); } \
                float lg[NE]; \
                _Pragma("unroll") for (int e = 0; e < NE; ++e) { float a = 0.f; \
                    _Pragma("unroll") for (int j = 0; j < 4; ++j) { const f32x4 w = *(const LAS f32x4*)(wrT + e * D + colb + 256 * j); a += (hv[j].x * w.x + hv[j].y * w.y) + (hv[j].z * w.z + hv[j].w * w.w); } \
                    lg[e] = wave_sum(a); } \
                int e0 = 0; float v0 = lg[0]; \
                _Pragma("unroll") for (int e = 1; e < NE; ++e) if (lg[e] > v0) { v0 = lg[e]; e0 = e; } \
                int e1 = -1; float v1 = -3.0e38f; \
                _Pragma("unroll") for (int e = 0; e < NE; ++e) if (e != e0 && lg[e] > v1) { v1 = lg[e]; e1 = e; } \
                if (e1 < 0) e1 = (e0 + 1) & 7;                                 \
                const float g0 = 1.0f / (1.0f + __expf(v1 - v0)), g1 = 1.0f - g0; \
                if (lane == 0) { tok_e[2 * m] = e0; tok_e[2 * m + 1] = e1; tok_g[2 * m] = g0; tok_g[2 * m + 1] = g1; \
                    __hip_atomic_fetch_add((LAS unsigned*)(F.lds + LDSCTL_OFF) + MW_CNT + e0, 1u, __ATOMIC_RELAXED, __HIP_MEMORY_SCOPE_WORKGROUP); \
                    __hip_atomic_fetch_add((LAS unsigned*)(F.lds + LDSCTL_OFF) + MW_CNT + e1, 1u, __ATOMIC_RELAXED, __HIP_MEMORY_SCOPE_WORKGROUP); } } while (0)
            {
                const int mb = 64 * c + 8 * wave; f32x4 pA[4], hA_[4], pB[4], hB_[4]; float sA, sB;
                P12_LOAD(pA, hA_, sA, mb);
#pragma unroll
                for (int i = 0; i < 8; i += 2) {
                    P12_LOAD(pB, hB_, sB, mb + i + 1);
                    P12_DO(pA, hA_, sA, mb + i);
                    P12_LOAD(pA, hA_, sA, mb + (i + 2 < 8 ? i + 2 : 0));
                    P12_DO(pB, hB_, sB, mb + i + 1);
                }
            }
#undef P12_LOAD
#undef P12_DO
            LDS_WAIT(); __syncthreads();
            if (F.tid < NE) ccnt[c * NE + F.tid] = (int)F.MISC[MW_CNT + F.tid];
            __syncthreads();
        }
    }
    GRID_BAR();

    PROBE_REP(13) {
    {
        PHASE_IDS();
        LAS int* cn = (LAS int*)(F.lds + RING_OFF);
        LAS int* ps = cn + NCHUNK * NE;
        LAS int* pre = ps + 64 * NE;
        LAS int* tot = pre + 64 * NE;
        LAS int* rst = tot + NE;
        LAS int* ent = rst + NE;
        LAS int* slt = ent + 128;
        LAS int* rnk = slt + 128;
        LAS int* w0c = rnk + 128;
        const int c0 = F.vcu; int te0 = 0; v4u ar0[8];
        if (c0 < NCHUNK) { if (F.tid < 128) te0 = tok_e[128 * c0 + F.tid];
#pragma unroll
            for (int i = 0; i < 8; ++i) ar0[i] = *(const GAS v4u*)(XN8 + (size_t)(64 * c0 + 8 * wave + i) * D + 16 * lane); }
        { int t_[NCHUNK * NE / (NWAVES * 64)];
#pragma unroll
            for (int i = 0; i < NCHUNK * NE / (NWAVES * 64); ++i) t_[i] = ccnt[F.tid + NWAVES * 64 * i];
#pragma unroll
            for (int i = 0; i < NCHUNK * NE / (NWAVES * 64); ++i) cn[F.tid + NWAVES * 64 * i] = t_[i]; }
        LDS_WAIT(); __syncthreads();
        { const int e = F.tid & 7, part = F.tid >> 3; ps[part * NE + e] = (cn[(4 * part + 0) * NE + e] + cn[(4 * part + 1) * NE + e]) + (cn[(4 * part + 2) * NE + e] + cn[(4 * part + 3) * NE + e]); }
        LDS_WAIT(); __syncthreads();
        { const int v = ps[lane * NE + wave]; int inc = v;
#pragma unroll
            for (int o = 1; o < 64; o <<= 1) { const int nb_ = __shfl_up(inc, o); if (lane >= o) inc += nb_; }
            pre[lane * NE + wave] = inc - v; if (lane == 63) tot[wave] = inc; }
        LDS_WAIT(); __syncthreads();
        if (F.tid == 0) { int ts = 0; for (int e = 0; e < NE; ++e) { F.MISC[MW_TS + e] = (unsigned)ts; rst[e] = ts * 256; ts += (tot[e] + 255) >> 8; } F.MISC[MW_TS + NE] = (unsigned)ts; }
        LDS_WAIT(); __syncthreads();
        for (int c = F.vcu; c < NCHUNK; c += F.G) {
            if (F.tid < 128) ent[F.tid] = c == c0 ? te0 : tok_e[128 * c + F.tid];
            LDS_WAIT(); __syncthreads();
            if (F.tid < 128) {
                const int e = ent[F.tid]; int rank = 0;
#pragma unroll
                for (int x = 0; x < NE; ++x) { const unsigned long long mk = __ballot(e == x); if (e == x) rank = __builtin_popcountll(mk & ((1ull << lane) - 1ull)); if (wave == 0 && lane == 0) w0c[x] = __builtin_popcountll(mk); }
                rnk[F.tid] = rank; }
            LDS_WAIT(); __syncthreads();
            if (F.tid < 128) { const int e = ent[F.tid]; const int rank = rnk[F.tid] + (F.tid >= 64 ? w0c[e] : 0);
                int base = rst[e] + pre[(c >> 2) * NE + e]; for (int q = 4 * (c >> 2); q < c; ++q) base += cn[q * NE + e];
                slt[F.tid] = base + rank; slot_of[128 * c + F.tid] = base + rank; }
            LDS_WAIT(); __syncthreads();
#pragma unroll
            for (int i = 0; i < 8; ++i) { const int rr = 8 * wave + i, m = 64 * c + rr; const int s0 = slt[2 * rr], s1 = slt[2 * rr + 1];
                v4u a = ar0[i]; if (c != c0) a = *(const GAS v4u*)(XN8 + (size_t)m * D + 16 * lane);
                *(GAS v4u*)(APERM + (size_t)s0 * D + 16 * lane) = a; *(GAS v4u*)(APERM + (size_t)s1 * D + 16 * lane) = a; }
            LDS_WAIT(); __syncthreads();
        }
    }
    GRID_BAR();
    }

    PROBE_REP(14) {
    {
        const int ntile = (int)F.MISC[MW_TS + NE];
        pg8::Gemm g{(const bf16*)APERM, (const bf16*)(ws + WS_WGUM), ntile * 256, 2 * FF, D / 2, (size_t)2 * FF * D}; pg8::MoeOrder S; S.init(ntile * 256, 2 * FF, F.G, (int)blockIdx.x); S.ts = (const volatile LAS int*)(F.MISC + MW_TS);
        pg8::EpiSwigluF8 E{MACT, FF, 1.0f / WGU_SCALE};
        pg8::gemm_phase<pg8::EpiSwigluF8, pg8::MoeOrder, MOE_ALIGN, PG8_SP2, true>(F.lds + RING_OFF, g, S, E);
    }
    GRID_BAR();
    }

    PROBE_REP(16) {
    {
        const int ntile = (int)F.MISC[MW_TS + NE];
        pg8::Gemm g{(const bf16*)MACT, (const bf16*)(ws + WS_WDM), ntile * 256, D, FF / 2, (size_t)D * FF}; pg8::MoeOrder S; S.init(ntile * 256, D, F.G, (int)blockIdx.x); S.ts = (const volatile LAS int*)(F.MISC + MW_TS);
        pg8::EpiF8Scale E{Y8, D, Y8_SCALE / WD_SCALE};
        const int pmfull = ((ntile * (D / 256)) / F.G) * F.G / (D / 256), nleft = (ntile - pmfull) * (D / 256); const bool split = pmfull > 0 && nleft > 0 && nleft * P16_KS <= F.G && F.G % (D / 256) == 0;
        if (split) S.init(pmfull * 256, D, F.G, (int)blockIdx.x);
        pg8::gemm_phase<pg8::EpiF8Scale, pg8::MoeOrder, PG8_ALIGN, PG8_SP2, true>(F.lds + RING_OFF, g, S, E);
        if (split) {
            pg8::Gemm g2 = g; g2.ntk = FF / 128 / P16_KS;
            pg8::SplitKOrder S2; S2.init(ntile * 256, D, F.G, (int)blockIdx.x); S2.ts = (const volatile LAS int*)(F.MISC + MW_TS); S2.pm0 = pmfull; S2.KS = P16_KS; S2.kpart = FF / P16_KS; S2.ntot = nleft * P16_KS;
            pg8::EpiBf16Part E2{YP, 1.0f / WD_SCALE};
            pg8::gemm_phase<pg8::EpiBf16Part, pg8::SplitKOrder, PG8_ALIGN, PG8_SP2, true>(F.lds + RING_OFF, g2, S2, E2);
        }
    }
    GRID_BAR();
    }

    PROBE_REP(17) {
    {
        PHASE_IDS();
        f32x4 ga[4];
#pragma unroll
        for (int j = 0; j < 4; ++j) ga[j] = *(const GAS f32x4*)(norm_g + 7 * D + colb + 256 * j);
        const unsigned bad = __hip_atomic_load((gu32*)((unsigned*)(F.ctl + CW_BAR) + XB_TMO), RLX_AGENT);
        const float qn = bad ? __builtin_nanf("") : 0.f;
        const int nrow = gw < M ? (M - gw + NGW - 1) / NGW : 0;
        const int ntile17 = (int)F.MISC[MW_TS + NE], pmf17 = ((ntile17 * (D / 256)) / F.G) * F.G / (D / 256), nleft17 = (ntile17 - pmf17) * (D / 256);
        const bool split17 = pmf17 > 0 && nleft17 > 0 && nleft17 * P16_KS <= F.G && F.G % (D / 256) == 0; const int pm17 = split17 ? pmf17 : MOE_MAXT + 1;
#define P17_LOAD(Y0_, Y1_, H_, i_) do { const int ii_ = (i_); const int m_ = gw + (base + ii_) * NGW; const int s0 = __builtin_amdgcn_readlane(rs0, ii_), s1 = __builtin_amdgcn_readlane(rs1, ii_); \
            _Pragma("unroll") for (int j = 0; j < 4; ++j) { Y0_[j] = ld_fp8x4(Y8 + (size_t)s0 * D + colb + 256 * j); Y1_[j] = ld_fp8x4(Y8 + (size_t)s1 * D + colb + 256 * j); H_[j] = ld_bf16x4(HB + (size_t)m_ * D + colb + 256 * j); } } while (0)
#define P17_DO(Y0_, Y1_, H_, i_) do { const int ii_ = (i_); const int m_ = gw + (base + ii_) * NGW; \
            const float g0 = __int_as_float(__builtin_amdgcn_readlane(__float_as_int(rg0), ii_)), g1 = __int_as_float(__builtin_amdgcn_readlane(__float_as_int(rg1), ii_)); \
            _Pragma("unroll") for (int j = 0; j < 4; ++j) Y0_[j] = Y0_[j] * g0 + Y1_[j] * g1; \
            const float r = rms_scale(ssq4(Y0_), D); \
            _Pragma("unroll") for (int j = 0; j < 4; ++j) *(GAS f32x4*)(out + (size_t)m_ * D + colb + 256 * j) = H_[j] + Y0_[j] * r * ga[j] + qn; } while (0)
        for (int base = 0; base < nrow; base += 64) {
            const int nb = nrow - base < 64 ? nrow - base : 64;
            int rs0 = 0, rs1 = 0; float rg0 = 0.f, rg1 = 0.f;
            if (lane < nb) { const int mi = gw + (base + lane) * NGW; rs0 = slot_of[2 * mi]; rs1 = slot_of[2 * mi + 1]; rg0 = tok_g[2 * mi] * (1.0f / Y8_SCALE); rg1 = tok_g[2 * mi + 1] * (1.0f / Y8_SCALE); }
            f32x4 yA0[4], yA1[4], hA_[4], yB0[4], yB1[4], hB_[4];
            P17_LOAD(yA0, yA1, hA_, 0);
            for (int i = 0; i < nb; i += 2) {
                P17_LOAD(yB0, yB1, hB_, i + 1 < nb ? i + 1 : 0);
                P17_DO(yA0, yA1, hA_, i);
                if (i + 1 >= nb) break;
                P17_LOAD(yA0, yA1, hA_, i + 2 < nb ? i + 2 : 0);
                P17_DO(yB0, yB1, hB_, i + 1);
            }
            if (split17) {
                const bool late = lane < nb && ((rs0 >> 8) >= pm17 || (rs1 >> 8) >= pm17);
                unsigned long long wm = __ballot(late);
                while (wm) { const int i = __builtin_ctzll(wm); wm &= wm - 1; const int m_ = gw + (base + i) * NGW;
                    const int s0 = __builtin_amdgcn_readlane(rs0, i), s1 = __builtin_amdgcn_readlane(rs1, i);
                    const float g0 = __int_as_float(__builtin_amdgcn_readlane(__float_as_int(rg0), i)), g1 = __int_as_float(__builtin_amdgcn_readlane(__float_as_int(rg1), i));
                    f32x4 y[4], hv[4], a0[4], a1[4]; u32x2 hh[4];
#pragma unroll
                    for (int j = 0; j < 4; ++j) hh[j] = *(const GAS u32x2*)(HB + (size_t)m_ * D + colb + 256 * j);
#define P17_SLOT(A_, s_) do { if (((s_) >> 8) >= pm17) { u32x2 w_[4][P16_KS]; \
                        _Pragma("unroll") for (int j = 0; j < 4; ++j) { const bf16* t_ = YP + ((size_t)(((((s_) >> 8) - pm17) * 4 + j) * P16_KS) * 256 + ((s_) & 255)) * 256 + colb; \
                            _Pragma("unroll") for (int p = 0; p < P16_KS; ++p) w_[j][p] = *(const GAS u32x2*)(t_ + (size_t)p * 65536); } \
                        _Pragma("unroll") for (int j = 0; j < 4; ++j) { f32x4 s4 = (f32x4){0.f, 0.f, 0.f, 0.f}; \
                            _Pragma("unroll") for (int p = 0; p < P16_KS; ++p) s4 += (f32x4){__uint_as_float(w_[j][p].x << 16), __uint_as_float(w_[j][p].x & 0xffff0000u), __uint_as_float(w_[j][p].y << 16), __uint_as_float(w_[j][p].y & 0xffff0000u)}; \
                            A_[j] = s4 * Y8_SCALE; } } \
                    else { int q_[4]; _Pragma("unroll") for (int j = 0; j < 4; ++j) q_[j] = *(const GAS int*)(Y8 + (size_t)(s_) * D + colb + 256 * j); \
                        _Pragma("unroll") for (int j = 0; j < 4; ++j) A_[j] = (f32x4){__builtin_amdgcn_cvt_f32_fp8(q_[j], 0), __builtin_amdgcn_cvt_f32_fp8(q_[j], 1), __builtin_amdgcn_cvt_f32_fp8(q_[j], 2), __builtin_amdgcn_cvt_f32_fp8(q_[j], 3)}; } } while (0)
                    P17_SLOT(a0, s0); P17_SLOT(a1, s1);
#undef P17_SLOT
#pragma unroll
                    for (int j = 0; j < 4; ++j) { y[j] = a0[j] * g0 + a1[j] * g1;
                        hv[j] = (f32x4){__uint_as_float(hh[j].x << 16), __uint_as_float(hh[j].x & 0xffff0000u), __uint_as_float(hh[j].y << 16), __uint_as_float(hh[j].y & 0xffff0000u)}; }
                    const float r = rms_scale(ssq4(y), D);
#pragma unroll
                    for (int j = 0; j < 4; ++j) *(GAS f32x4*)(out + (size_t)m_ * D + colb + 256 * j) = hv[j] + y[j] * r * ga[j] + qn; }
            }
        }
#undef P17_LOAD
#undef P17_DO
    }
    if (PROBE == 17) GRID_BAR();
    }
#undef GRID_BAR
#undef THIN_RES_NORM
#undef THIN_LOAD
#undef THIN_DO
}

extern "C" void kernel_launch(void* const* d_in, const int* in_sizes, int n_in, void* d_out, int out_size, void* d_ws, size_t ws_size, hipStream_t stream) {
    static int grid = 0;
    if (grid == 0) {
        if (n_in != 16 || in_sizes[0] != M * D || out_size != M * D || ws_size < WS_END) { fprintf(stderr, "kernel_launch: built for 16 inputs, x and out of %d floats, >= %zu bytes of workspace; got n_in %d, in0 %d, out %d, ws %zu; nothing launched\n", M * D, (size_t)WS_END, n_in, n_in > 0 ? in_sizes[0] : -1, out_size, ws_size); grid = -1; return; }
        int dev = 0, cus = 0, per_cu = 0;
        if (hipGetDevice(&dev) != hipSuccess || hipDeviceGetAttribute(&cus, hipDeviceAttributeMultiprocessorCount, dev) != hipSuccess) { fprintf(stderr, "kernel_launch: hipGetDevice / hipDeviceGetAttribute failed; nothing launched\n"); grid = -1; return; }
        if (hipFuncSetAttribute((const void*)fwd_kernel, hipFuncAttributeMaxDynamicSharedMemorySize, LDS_BYTES) != hipSuccess) { fprintf(stderr, "kernel_launch: hipFuncSetAttribute failed (%d bytes of dynamic LDS); nothing launched\n", LDS_BYTES); grid = -1; return; }
        if (hipOccupancyMaxActiveBlocksPerMultiprocessor(&per_cu, (const void*)fwd_kernel, NWAVES * 64, LDS_BYTES) != hipSuccess || per_cu < 1) { fprintf(stderr, "kernel_launch: occupancy query reports %d workgroups per CU; nothing launched\n", per_cu); (void)hipGetLastError(); grid = -1; return; }
        grid = cus;
    }
    if (grid < 0) return;
    if (hipMemsetAsync((char*)d_ws + WS_CTL, 0, CTL_ZERO_BYTES, stream) != hipSuccess) { fprintf(stderr, "kernel_launch: hipMemsetAsync of the control words failed; nothing launched\n"); return; }
    Args a{};
    for (int i = 0; i < 16; ++i) a.in[i] = (const float*)d_in[i];
    a.out = (float*)d_out; a.ws = (unsigned char*)d_ws;
    hipLaunchKernelGGL(fwd_kernel, dim3(grid), dim3(NWAVES * 64), LDS_BYTES, stream, a);
    const hipError_t le = hipPeekAtLastError();
    if (le != hipSuccess) fprintf(stderr, "kernel_launch: launch failed: %s (grid %d x %d threads, %d B LDS)\n", hipGetErrorName(le), grid, NWAVES * 64, LDS_BYTES);
}
```
